# Optimizing an MI355X kernel written in HIP

```python
import math
import jax, jax.numpy as jnp
from jax import lax
import numpy as np

D_MODEL = 1024
BATCH = 2
SEQ = 8192
DEPTH = 2

GRID_W = 64
CTX_LEN = 256
EPS = 1e-6
ROPE_BASE = 10000.0
HEAD_DIM = 64
MIX_WIDTH = D_MODEL
NA_WIDTH = D_MODEL // 2
NA_HEADS = NA_WIDTH // HEAD_DIM
NA_KH_MAX = 8
NA_KW = 16
DIFF_WIDTH = D_MODEL // 4
DIFF_HEADS = 4
DIFF_V_DIM = DIFF_WIDTH // DIFF_HEADS
DIFF_QK_DIM = DIFF_V_DIM // 2
FNET_WIDTH = D_MODEL // 4
FNET_GROUPS = 4
FNET_GROUP_DIM = FNET_WIDTH // FNET_GROUPS
NA_Q0 = 0
NA_K0 = NA_Q0 + NA_WIDTH
NA_V0 = NA_K0 + NA_WIDTH
DQ0 = NA_V0 + NA_WIDTH
DK0 = DQ0 + DIFF_HEADS * 2 * DIFF_QK_DIM
DV0 = DK0 + DIFF_HEADS * 2 * DIFF_QK_DIM
FN0 = DV0 + DIFF_WIDTH
IN_WIDTH = FN0 + FNET_WIDTH
D_FF = 2816
CONV_W = 3
Q_BLOCK = 128

kernel_name = 'hybrid_na_diff_fnet_prefix_block'


def _rmsnorm(x, g):
    x32 = x.astype(jnp.float32)
    y = x32 * lax.rsqrt(jnp.mean(x32 * x32, axis=-1, keepdims=True) + EPS)
    return (y * g.astype(jnp.float32)).astype(x.dtype)


def _modulate(h, shift, scale):
    return h * (1 + scale) + shift


def _rope_1d(x, pos):
    m = x.shape[-1]
    inv = ROPE_BASE ** (-jnp.arange(0, m, 2, dtype=jnp.float32) / m)
    ang = pos.astype(jnp.float32)[:, None] * inv[None, :]
    cos = jnp.cos(ang)[None, :, None, :]
    sin = jnp.sin(ang)[None, :, None, :]
    x32 = x.astype(jnp.float32)
    x1, x2 = x32[..., : m // 2], x32[..., m // 2:]
    return jnp.concatenate([x1 * cos - x2 * sin, x1 * sin + x2 * cos], axis=-1).astype(x.dtype)


def _axial_rope(x, rows, cols):
    d = x.shape[-1]
    return jnp.concatenate([_rope_1d(x[..., : d // 2], rows), _rope_1d(x[..., d // 2:], cols)], axis=-1)


def _split_heads(p, na_q_g, na_k_g, d_q_g, d_k_g):
    B, L, _ = p.shape
    na_q = _rmsnorm(p[..., NA_Q0:NA_K0].reshape(B, L, NA_HEADS, HEAD_DIM), na_q_g)
    na_k = _rmsnorm(p[..., NA_K0:NA_V0].reshape(B, L, NA_HEADS, HEAD_DIM), na_k_g)
    na_v = p[..., NA_V0:DQ0].reshape(B, L, NA_HEADS, HEAD_DIM)
    dq = _rmsnorm(p[..., DQ0:DK0].reshape(B, L, DIFF_HEADS, 2, DIFF_QK_DIM), d_q_g)
    dk = _rmsnorm(p[..., DK0:DV0].reshape(B, L, DIFF_HEADS, 2, DIFF_QK_DIM), d_k_g)
    dv = p[..., DV0:FN0].reshape(B, L, DIFF_HEADS, DIFF_V_DIM)
    fu = p[..., FN0:IN_WIDTH]
    return na_q, na_k, na_v, dq, dk, dv, fu


def _neighbourhood_attention(q, k, v, kc, vc, rpb, n_rows):
    B, S, H, Dh = q.shape
    kh = min(NA_KH_MAX, n_rows)
    n_keys = kh * NA_KW
    scale = Dh ** -0.5
    cols = jnp.arange(GRID_W)
    col_start = jnp.clip(cols - NA_KW // 2, 0, GRID_W - NA_KW)
    key_cols = col_start[:, None] + jnp.arange(NA_KW)[None, :]
    dc = key_cols - cols[:, None] + (NA_KW - 1)
    q_rows = q.reshape(B, n_rows, GRID_W, H, Dh).transpose(1, 0, 2, 3, 4)

    def row_block(args):
        r, q_r = args
        row_start = jnp.clip(r - kh // 2, 0, n_rows - kh)
        key_rows = row_start + jnp.arange(kh)
        idx = (key_rows[None, :, None] * GRID_W + key_cols[:, None, :]).reshape(GRID_W, n_keys)
        k_g = k[:, idx]
        v_g = v[:, idx]
        dr = key_rows - r + (NA_KH_MAX - 1)
        bias = rpb[:, dr[None, :, None], dc[:, None, :]].reshape(H, GRID_W, n_keys)
        s_loc = jnp.einsum('bqhd,bqnhd->bhqn', q_r, k_g).astype(jnp.float32) * scale + bias[None].astype(jnp.float32)
        s_ctx = jnp.einsum('bqhd,bchd->bhqc', q_r, kc).astype(jnp.float32) * scale
        p = jax.nn.softmax(jnp.concatenate([s_loc, s_ctx], axis=-1), axis=-1).astype(v.dtype)
        return (jnp.einsum('bhqn,bqnhd->bqhd', p[..., :n_keys], v_g)
                + jnp.einsum('bhqc,bchd->bqhd', p[..., n_keys:], vc))

    out = lax.map(row_block, (jnp.arange(n_rows), q_rows))
    return out.transpose(1, 0, 2, 3, 4).reshape(B, S, H, Dh)


def _dense_attention(q, k, v):
    s = jnp.einsum('bqhd,bkhd->bhqk', q, k).astype(jnp.float32) * q.shape[-1] ** -0.5
    p = jax.nn.softmax(s, axis=-1).astype(v.dtype)
    return jnp.einsum('bhqk,bkhd->bqhd', p, v)


def _diff_attend(q1, q2, k1, k2, v, lam):
    scale = q1.shape[-1] ** -0.5
    s1 = jnp.einsum('bqhd,bkhd->bhqk', q1, k1).astype(jnp.float32) * scale
    s2 = jnp.einsum('bqhd,bkhd->bhqk', q2, k2).astype(jnp.float32) * scale
    p = jax.nn.softmax(s1, axis=-1) - lam * jax.nn.softmax(s2, axis=-1)
    return jnp.einsum('bhqk,bkhe->bqhe', p.astype(v.dtype), v)


def _diff_attention_latent(q1, q2, k1, k2, v, k1c, k2c, vc, lam):
    B, S, H, d = q1.shape
    kk1 = jnp.concatenate([k1, k1c], axis=1)
    kk2 = jnp.concatenate([k2, k2c], axis=1)
    vv = jnp.concatenate([v, vc], axis=1)
    nb = S // Q_BLOCK
    q1b = q1.reshape(B, nb, Q_BLOCK, H, d).transpose(1, 0, 2, 3, 4)
    q2b = q2.reshape(B, nb, Q_BLOCK, H, d).transpose(1, 0, 2, 3, 4)
    out = lax.map(lambda a: _diff_attend(a[0], a[1], kk1, kk2, vv, lam), (q1b, q2b))
    return out.transpose(1, 0, 2, 3, 4).reshape(B, S, H, v.shape[-1])


def _fourier(u):
    B, L, _ = u.shape
    g = u.reshape(B, L, FNET_GROUPS, FNET_GROUP_DIM).astype(jnp.float32)
    f = jnp.fft.fftn(g, axes=(1, 3), norm='ortho').real
    return f.reshape(B, L, FNET_WIDTH).astype(u.dtype)


def _merge(na_o, diff_o, four_u, subln_g, lam_init, w_four, w_out):
    B, L = na_o.shape[:2]
    diff_o = _rmsnorm(diff_o, subln_g) * (1.0 - lam_init)
    four = _fourier(four_u) @ w_four
    y = jnp.concatenate([na_o.reshape(B, L, NA_WIDTH), diff_o.reshape(B, L, DIFF_WIDTH), four], axis=-1)
    return y @ w_out


def _conv_ffn(h, w_up, conv_w, conv_b, w_down):
    u = h @ w_up
    up = jnp.pad(u, ((0, 0), (1, 1), (0, 0)))
    u = up[:, :-2] * conv_w[0] + up[:, 1:-1] * conv_w[1] + up[:, 2:] * conv_w[2] + conv_b
    gate, val = jnp.split(u, 2, axis=-1)
    return (jax.nn.silu(gate) * val) @ w_down


def setup_inputs(seed: int = 0) -> dict:
    key = jax.random.key(seed)
    ks = jax.random.split(key, 22)
    D = D_MODEL

    def nrm(k, shape, s):
        return jax.random.normal(k, shape, jnp.float32) * s

    centre = (jnp.arange(CONV_W) == CONV_W // 2).astype(jnp.float32)[None, :, None]
    return {
        'x': nrm(ks[0], (BATCH, SEQ, D), 1.0),
        'c': nrm(ks[1], (BATCH, D), 1.0),
        'ctx': nrm(ks[2], (BATCH, CTX_LEN, D), 1.0),
        'c_ctx': nrm(ks[3], (D,), 1.0),
        'w_mod': nrm(ks[4], (DEPTH, D, 6 * D), 0.5 * D ** -0.5),
        'b_mod': nrm(ks[5], (DEPTH, 6 * D), 0.02),
        'norm1_g': 1.0 + nrm(ks[6], (DEPTH, D), 0.05),
        'w_in': nrm(ks[7], (DEPTH, D, IN_WIDTH), D ** -0.5),
        'na_q_g': 1.0 + nrm(ks[8], (DEPTH, HEAD_DIM), 0.05),
        'na_k_g': 1.0 + nrm(ks[9], (DEPTH, HEAD_DIM), 0.05),
        'na_rpb': nrm(ks[10], (DEPTH, NA_HEADS, 2 * NA_KH_MAX - 1, 2 * NA_KW - 1), 0.1),
        'diff_q_g': 1.0 + nrm(ks[11], (DEPTH, DIFF_QK_DIM), 0.05),
        'diff_k_g': 1.0 + nrm(ks[12], (DEPTH, DIFF_QK_DIM), 0.05),
        'diff_lambda': nrm(ks[13], (DEPTH, 4, DIFF_QK_DIM), 0.1),
        'diff_subln_g': 1.0 + nrm(ks[14], (DEPTH, DIFF_V_DIM), 0.05),
        'w_fourier': nrm(ks[15], (DEPTH, FNET_WIDTH, FNET_WIDTH), FNET_WIDTH ** -0.5),
        'w_out': nrm(ks[16], (DEPTH, MIX_WIDTH, D), MIX_WIDTH ** -0.5),
        'norm2_g': 1.0 + nrm(ks[17], (DEPTH, D), 0.05),
        'w_up': nrm(ks[18], (DEPTH, D, 2 * D_FF), D ** -0.5),
        'conv_w': centre + nrm(ks[19], (DEPTH, CONV_W, 2 * D_FF), 0.3),
        'conv_b': nrm(ks[20], (DEPTH, 2 * D_FF), 0.02),
        'w_down': nrm(ks[21], (DEPTH, D_FF, D), D_FF ** -0.5),
    }


def reference(x, c, ctx, c_ctx, w_mod, b_mod, norm1_g, w_in, na_q_g, na_k_g, na_rpb,
              diff_q_g, diff_k_g, diff_lambda, diff_subln_g, w_fourier, w_out, norm2_g,
              w_up, conv_w, conv_b, w_down):
    B, S, D = x.shape
    n_rows = S // GRID_W
    pos = jnp.arange(S)
    rows, cols = pos // GRID_W, pos % GRID_W
    cx = ctx
    for l in range(DEPTH):
        lam_init = 0.8 - 0.6 * math.exp(-0.3 * l)
        lq1, lk1, lq2, lk2 = (diff_lambda[l, i].astype(jnp.float32) for i in range(4))
        lam = jnp.exp(jnp.sum(lq1 * lk1)) - jnp.exp(jnp.sum(lq2 * lk2)) + lam_init

        mod_x = jax.nn.silu(c) @ w_mod[l] + b_mod[l]
        mod_c = jax.nn.silu(c_ctx) @ w_mod[l] + b_mod[l]
        sh1, sc1, g1, sh2, sc2, g2 = jnp.split(mod_x[:, None, :], 6, axis=-1)
        csh1, csc1, cg1, csh2, csc2, cg2 = jnp.split(mod_c, 6)

        hx = _modulate(_rmsnorm(x, norm1_g[l]), sh1, sc1)
        hc = _modulate(_rmsnorm(cx, norm1_g[l]), csh1, csc1)
        nqx, nkx, nvx, dqx, dkx, dvx, fux = _split_heads(hx @ w_in[l], na_q_g[l], na_k_g[l], diff_q_g[l], diff_k_g[l])
        nqc, nkc, nvc, dqc, dkc, dvc, fuc = _split_heads(hc @ w_in[l], na_q_g[l], na_k_g[l], diff_q_g[l], diff_k_g[l])

        na_x = _neighbourhood_attention(nqx, nkx, nvx, nkc, nvc, na_rpb[l], n_rows)
        q1x = _axial_rope(dqx[..., 0, :], rows, cols)
        q2x = _axial_rope(dqx[..., 1, :], rows, cols)
        k1x = _axial_rope(dkx[..., 0, :], rows, cols)
        k2x = _axial_rope(dkx[..., 1, :], rows, cols)
        diff_x = _diff_attention_latent(q1x, q2x, k1x, k2x, dvx, dkc[..., 0, :], dkc[..., 1, :], dvc, lam)
        x = x + g1 * _merge(na_x, diff_x, fux, diff_subln_g[l], lam_init, w_fourier[l], w_out[l])
        x = x + g2 * _conv_ffn(_modulate(_rmsnorm(x, norm2_g[l]), sh2, sc2), w_up[l], conv_w[l], conv_b[l], w_down[l])

        if l < DEPTH - 1:
            na_c = _dense_attention(nqc, nkc, nvc)
            diff_c = _diff_attend(dqc[..., 0, :], dqc[..., 1, :], dkc[..., 0, :], dkc[..., 1, :], dvc, lam)
            cx = cx + cg1 * _merge(na_c, diff_c, fuc, diff_subln_g[l], lam_init, w_fourier[l], w_out[l])
            cx = cx + cg2 * _conv_ffn(_modulate(_rmsnorm(cx, norm2_g[l]), csh2, csc2), w_up[l], conv_w[l], conv_b[l], w_down[l])
    return x
```

```cpp
#include <hip/hip_runtime.h>
#include <hip/hip_cooperative_groups.h>
#include <cstdio>
#include <cstdint>
namespace cg = cooperative_groups;

#define LAS __attribute__((address_space(3)))
typedef unsigned short bf16_t;
typedef short bf16x8 __attribute__((ext_vector_type(8)));
typedef short s16x4 __attribute__((ext_vector_type(4)));
typedef float f32x4 __attribute__((ext_vector_type(4)));
typedef float f32x2 __attribute__((ext_vector_type(2)));
typedef float f32x16 __attribute__((ext_vector_type(16)));
typedef unsigned u32x4 __attribute__((ext_vector_type(4)));
typedef unsigned u32x2 __attribute__((ext_vector_type(2)));
typedef __bf16 bf16x2_t __attribute__((ext_vector_type(2)));

constexpr int SEQ = 8192, DM = 1024, CTXL = 256, NLAT = 2 * SEQ, MT = NLAT + 2 * CTXL;
constexpr int PP = 2304;
constexpr int NAQ0 = 0, NAK0 = 512, NAV0 = 1024, DQ0 = 1536, DK0 = 1792, DV0 = 2048, FN0 = 2304, INW = 2560;
constexpr int NIN = 2816;
constexpr int DFF = 2816;
constexpr float EPS = 1e-6f, LOG2E = 1.4426950408889634f;

__device__ __forceinline__ unsigned cvtpk(float lo, float hi) { f32x2 v = {lo, hi}; bf16x2_t b = __builtin_convertvector(v, bf16x2_t); return __builtin_bit_cast(unsigned, b); }
__device__ __forceinline__ int lane_fresh() { int l; asm volatile("v_mbcnt_lo_u32_b32 %0, -1, 0\n\tv_mbcnt_hi_u32_b32 %0, -1, %0" : "=v"(l)); return l; }
__device__ __forceinline__ int lane_fresh();
__device__ __forceinline__ float bperm_xor(float v, int m) { int l; asm volatile("v_mbcnt_lo_u32_b32 %0, -1, 0\n\tv_mbcnt_hi_u32_b32 %0, -1, %0" : "=v"(l)); return __builtin_bit_cast(float, __builtin_amdgcn_ds_bpermute((l ^ m) << 2, __builtin_bit_cast(int, v))); }
#define SWZ_XOR(v, m) bperm_xor((v), (m))
__device__ __forceinline__ float sum_xor32(float v) { return v + bperm_xor(v, 32); }
__device__ __forceinline__ bf16_t f2bf(float f) { return (bf16_t)(cvtpk(f, 0.f) & 0xffffu); }

namespace pg8 {
constexpr int BM = 256, BK = 64, HALF = 128, HTB = HALF * BK * 2, STAGE_BYTES = 8 * HTB, NXCD = 8, WGM = 8;
__host__ __device__ __forceinline__ int lds_byte(int r, int c) { const int st = (r >> 4) * 2 + (c >> 5), rr = r & 15, cc = c & 31, ob = rr * 64 + cc * 2; return st * 1024 + (ob ^ (((ob >> 9) & 1) << 5)); }
__host__ __device__ __forceinline__ void stage_rc(int b, int& R, int& C) { const int st = b / 1024, sb = b % 1024, swz = sb ^ (((sb >> 9) & 1) << 5); R = (st >> 1) * 16 + swz / 64; C = (st & 1) * 32 + (swz % 64) / 2; }
__host__ __device__ __forceinline__ int perm32(int rho) { const int n = rho >> 4, i = rho & 15; return 8 * (i >> 2) + 4 * n + (i & 3); }

struct Unit { int pm, pn, kc; };
struct Gemm { const bf16_t* A; const bf16_t* Bt; int K; int amode; size_t a_half, a_tile; int lda, ldb; };

struct TileOrder {
    int nM, nN, nwg, G, c, nk;
    __device__ void init(int nM_, int nN_, int G_, int c_, int nk_ = 0) { nM = nM_; nN = nN_; nwg = nM * nN; G = G_; c = c_; nk = nk_; }
    __device__ bool next(int i, Unit& u) const {
        if (nk > 0) { const int L2 = i * G + c; if (L2 >= 8 * nk) return false; u.pm = 64 + (L2 & 1); u.pn = (L2 >> 1) & 3; u.kc = L2 >> 3; return true; }
        const long L = (long)i * G + c; if (L >= nwg) return false;
        int wgid = (int)L; { const int q = nwg / NXCD, r = nwg % NXCD, xcd = wgid % NXCD, off = wgid / NXCD; wgid = (xcd < r ? xcd * (q + 1) : r * (q + 1) + (xcd - r) * q) + off; }
        const int nig = WGM * nN, gid = wgid / nig, fm = gid * WGM, gsz = (nM - fm) < WGM ? (nM - fm) : WGM;
        u.pm = fm + ((wgid % nig) % gsz); u.pn = (wgid % nig) / gsz; u.kc = 0; return true;
    }
};

template <class Epi, class Sched, bool ALIGN_EPI = true>
__device__ __forceinline__ void gemm_phase(LAS unsigned char* lds, const Gemm g, const Sched& S, const Epi& E, int wid) {
    const int lane = lane_fresh(), tid = wid * 64 + lane, wr = wid >> 2, wc = wid & 3, fr = lane & 15, fq = lane >> 4;
    const int K = g.K, nt = K / BK;
    unsigned voffA[2], voffB[2];
#pragma unroll
    for (int i = 0; i < 2; ++i) { int R, C; stage_rc(tid * 16 + i * 8192, R, C); const int Rb = Epi::PERM ? ((R & ~31) + perm32(R & 31)) : R;
        const int Ra = g.amode == 1 ? (126 * (R >> 6) + 8 * (R & 15) + ((R >> 4) & 3)) : (g.amode == 2 ? (64 * ((R >> 4) & 3) + 16 * (R >> 6) + (R & 15)) : R);
        voffA[i] = (unsigned)(Ra * g.lda + C) * 2u; voffB[i] = (unsigned)(Rb * g.ldb + C) * 2u; }
    const size_t kstep = (size_t)(BK * 2);
    const size_t hstepB = (size_t)HALF * g.ldb * 2, tstepB = 2 * hstepB, kchunk = (size_t)K * 2;
    const size_t hstepA = g.a_half, tstepA = g.a_tile;
    const unsigned ldsw = (unsigned)wid * 1024u;
    const int aoff = lds_byte(wr * 64 + fr, fq * 8), boff = lds_byte(wc * 32 + fr, fq * 8);
#define PG8_SA(b, h) (((b) * 2 + (h)) * HTB)
#define PG8_SB(b, h) ((4 + (b) * 2 + (h)) * HTB)
#define PG8_STAGE(bufoff, gbase, voff) do { _Pragma("unroll") for (int _i = 0; _i < 2; ++_i) \
        __builtin_amdgcn_global_load_lds((const unsigned*)((const char*)(gbase) + (voff)[_i]), (LAS unsigned*)(lds + (bufoff) + ldsw + _i * 8192), 16, 0, 0); } while (0)
#define PG8_LDA(dst, b, h) do { _Pragma("unroll") for (int m = 0; m < 4; ++m) _Pragma("unroll") for (int k = 0; k < 2; ++k) dst[m][k] = *(const LAS bf16x8*)(lds + PG8_SA(b, h) + aoff + m * 2048 + k * 1024); } while (0)
#define PG8_LDB(dst, b, h) do { _Pragma("unroll") for (int n = 0; n < 2; ++n) _Pragma("unroll") for (int k = 0; k < 2; ++k) dst[n][k] = *(const LAS bf16x8*)(lds + PG8_SB(b, h) + boff + n * 2048 + k * 1024); } while (0)
#define PG8_MMA(ai, bj, At, Bt) do { __builtin_amdgcn_s_setprio(1); _Pragma("unroll") for (int m = 0; m < 4; ++m) _Pragma("unroll") for (int n = 0; n < 2; ++n) _Pragma("unroll") for (int k = 0; k < 2; ++k) \
        acc[ai][bj][m][n] = __builtin_amdgcn_mfma_f32_16x16x32_bf16(Bt[n][k], At[m][k], acc[ai][bj][m][n], 0, 0, 0); __builtin_amdgcn_s_setprio(0); } while (0)
#define PG8_WAIT_V(n) asm volatile("s_waitcnt vmcnt(" #n ")" ::: "memory")
#define PG8_WAIT_L(n) asm volatile("s_waitcnt lgkmcnt(" #n ")" ::: "memory")
#define PG8_BAR __builtin_amdgcn_s_barrier()
#define PG8_SCHED __builtin_amdgcn_sched_barrier(0)
    Unit cur, nxt; int ui = 0;
    if (!S.next(0, cur)) return;
    f32x4 acc[2][2][4][2];
#pragma unroll
    for (int a = 0; a < 2; ++a)
#pragma unroll
        for (int b = 0; b < 2; ++b)
#pragma unroll
            for (int m = 0; m < 4; ++m)
#pragma unroll
                for (int n = 0; n < 2; ++n) acc[a][b][m][n] = (f32x4){0.f, 0.f, 0.f, 0.f};
    bf16x8 At[4][2], B0[2][2], B1[2][2];
#define PG8_ABASE(pm_) (g.amode == 2 ? (size_t)(((pm_) >> 1) * 512 + ((pm_) & 1) * 32) * g.lda * 2 : (size_t)(pm_) * tstepA)
    const char* cA = (const char*)g.A + PG8_ABASE(cur.pm) + (size_t)cur.kc * kchunk; const char* cB = (const char*)g.Bt + (size_t)cur.pn * tstepB + (size_t)cur.kc * kchunk;
    {
        PG8_STAGE(PG8_SB(0, 0), cB, voffB); PG8_STAGE(PG8_SB(0, 1), cB + hstepB, voffB); PG8_STAGE(PG8_SA(0, 0), cA, voffA); PG8_STAGE(PG8_SA(0, 1), cA + hstepA, voffA);
        if (wr == 1) PG8_BAR;
        PG8_WAIT_V(2); PG8_BAR;
        PG8_STAGE(PG8_SB(1, 0), cB + kstep, voffB); PG8_STAGE(PG8_SA(1, 0), cA + kstep, voffA); PG8_STAGE(PG8_SB(1, 1), cB + hstepB + kstep, voffB);
        PG8_WAIT_V(6); PG8_BAR;
    }
    for (;;) {
        const bool has_next = S.next(ui + 1, nxt);
        const char* nA = has_next ? (const char*)g.A + PG8_ABASE(nxt.pm) + (size_t)nxt.kc * kchunk : cA; const char* nB = has_next ? (const char*)g.Bt + (size_t)nxt.pn * tstepB + (size_t)nxt.kc * kchunk : cB;
        for (int t = 0; t < nt; t += 2) {
            const bool last = (t == nt - 2);
            const char* a1 = cA + (size_t)(t + 1) * kstep;
            const char* a2 = last ? nA : cA + (size_t)(t + 2) * kstep; const char* b2 = last ? nB : cB + (size_t)(t + 2) * kstep;
            const char* a3 = a2 + kstep; const char* b3 = b2 + kstep;
            PG8_LDB(B0, 0, 0); PG8_LDB(B1, 0, 1); PG8_SCHED; PG8_LDA(At, 0, 0); PG8_STAGE(PG8_SA(1, 1), a1 + hstepA, voffA);
            PG8_WAIT_V(8); PG8_WAIT_L(0); PG8_BAR; PG8_MMA(0, 0, At, B0); PG8_MMA(0, 1, At, B1); PG8_BAR; PG8_SCHED;
            PG8_LDA(At, 0, 1); PG8_STAGE(PG8_SB(0, 0), b2, voffB); PG8_STAGE(PG8_SB(0, 1), b2 + hstepB, voffB); PG8_STAGE(PG8_SA(0, 0), a2, voffA);
            PG8_WAIT_V(8); PG8_WAIT_L(0); PG8_BAR; PG8_MMA(1, 0, At, B0); PG8_MMA(1, 1, At, B1); PG8_BAR; PG8_SCHED;
            PG8_LDB(B0, 1, 0); PG8_LDB(B1, 1, 1); PG8_SCHED; PG8_LDA(At, 1, 0); PG8_STAGE(PG8_SA(0, 1), a2 + hstepA, voffA);
            PG8_WAIT_V(8); PG8_WAIT_L(0); PG8_BAR; PG8_MMA(0, 0, At, B0); PG8_MMA(0, 1, At, B1); PG8_BAR; PG8_SCHED;
            PG8_LDA(At, 1, 1); PG8_STAGE(PG8_SB(1, 0), b3, voffB); PG8_STAGE(PG8_SB(1, 1), b3 + hstepB, voffB); PG8_STAGE(PG8_SA(1, 0), a3, voffA);
            PG8_WAIT_V(8); PG8_WAIT_L(0); PG8_BAR; PG8_MMA(1, 0, At, B0); PG8_MMA(1, 1, At, B1); PG8_BAR; PG8_SCHED;
        }
        if constexpr (ALIGN_EPI) { if (wr == 0) PG8_BAR; }
        { const int ln = lane_fresh(); E(acc, cur, wr, wc, ln & 15, ln >> 4); }
        if (!has_next) break;
#pragma unroll
        for (int a = 0; a < 2; ++a)
#pragma unroll
            for (int b = 0; b < 2; ++b)
#pragma unroll
                for (int m = 0; m < 4; ++m)
#pragma unroll
                    for (int n = 0; n < 2; ++n) acc[a][b][m][n] = (f32x4){0.f, 0.f, 0.f, 0.f};
        cur = nxt; cA = nA; cB = nB; ++ui;
        if constexpr (ALIGN_EPI) { if (wr == 1) PG8_BAR; }
    }
    PG8_WAIT_V(0);
    if constexpr (!ALIGN_EPI) { if (wr == 0) PG8_BAR; }
    PG8_BAR;
#undef PG8_ABASE
#undef PG8_SA
#undef PG8_SB
#undef PG8_STAGE
#undef PG8_LDA
#undef PG8_LDB
#undef PG8_MMA
#undef PG8_WAIT_V
#undef PG8_WAIT_L
#undef PG8_BAR
#undef PG8_SCHED
}
}
#define RLX_AGENT __ATOMIC_RELAXED, __HIP_MEMORY_SCOPE_AGENT
#define XB_TMO      128
#define XB_XCNT(j)  (256  + 64 * (j))
#define XB_XSUB(j)  (1280 + 64 * (j))
#define XB_XGEN(j)  (2304 + 64 * (j))
#define XB_TOP      3328
#define XB_TOPGEN   3392
#define XCD_BAR_WORDS 3456
#define XB_SPIN_CAP (1u << 18)

__device__ __forceinline__ unsigned xb_ld(unsigned* p)              { return __hip_atomic_load(p, __ATOMIC_RELAXED, __HIP_MEMORY_SCOPE_AGENT); }
__device__ __forceinline__ unsigned xb_add(unsigned* p, unsigned v) { return __hip_atomic_fetch_add(p, v, __ATOMIC_RELAXED, __HIP_MEMORY_SCOPE_AGENT); }
__device__ __forceinline__ unsigned xb_xcc_id() { return (unsigned)__builtin_amdgcn_s_getreg((3 << 11) | 20) & 0xFu; }
#define XB_SPIN(cond, bar) do { unsigned _sp = 0; while (cond) { __builtin_amdgcn_s_sleep(1); \
    if ((++_sp & 255u) == 0u) { if (xb_ld(&(bar)[XB_TMO])) break; if (_sp > XB_SPIN_CAP) { atomicAdd(&(bar)[XB_TMO], 1u); break; } } } } while (0)

struct XcdBarrier {
    unsigned* bar; unsigned x;
    volatile LAS unsigned* st;
};

__device__ __forceinline__ XcdBarrier xcd_barrier_post(unsigned* bar, volatile LAS unsigned* st, bool t0) {
    XcdBarrier b; b.bar = bar; b.x = xb_xcc_id(); b.st = st;
    if (t0) (void)xb_add(&bar[XB_XCNT(b.x)], 1u);
    return b;
}
__device__ __forceinline__ void xcd_barrier_complete(unsigned* bar, unsigned x, unsigned& nloc, unsigned& nx) {
    const unsigned G = gridDim.x * gridDim.y * gridDim.z;
    unsigned sum, cnt, mine, sp = 0u;
    for (;;) {
        sum = 0u; cnt = 0u; mine = 0u;
#pragma unroll
        for (unsigned j = 0; j < 16; ++j) { const unsigned c = xb_ld(&bar[XB_XCNT(j)]); sum += c; cnt += (c > 0u) ? 1u : 0u; mine = (j == x) ? c : mine; }
        if (sum == G) break;
        __builtin_amdgcn_s_sleep(1);
        if ((++sp & 255u) == 0u) { if (xb_ld(&bar[XB_TMO])) break; if (sp > XB_SPIN_CAP) { atomicAdd(&bar[XB_TMO], 1u); break; } }
    }
    nloc = mine > 0u ? mine : 1u; nx = cnt > 0u ? cnt : 1u;
}

__device__ __forceinline__ void xcd_barrier(const XcdBarrier& b, bool t0) {
    asm volatile("s_waitcnt vmcnt(0)" ::: "memory");
    __syncthreads();
    if (t0) {
        unsigned* bar = b.bar;
        __builtin_amdgcn_s_waitcnt(0);
        unsigned nloc = b.st[0], nx = b.st[1];
        if (nloc == 0u) { xcd_barrier_complete(bar, b.x, nloc, nx); b.st[0] = nloc; b.st[1] = nx; }
        const unsigned old = xb_add(&bar[XB_XSUB(b.x)], 1u);
        const unsigned gen = old / nloc;
        if (old + 1u == (gen + 1u) * nloc) {
            __builtin_amdgcn_fence(__ATOMIC_RELEASE, "agent");
            asm volatile("s_waitcnt vmcnt(0)" ::: "memory");
            const unsigned og = xb_add(&bar[XB_TOP], 1u);
            const unsigned tg = og / nx;
            if (og + 1u == (tg + 1u) * nx) xb_add(&bar[XB_TOPGEN], 1u);
            else XB_SPIN(xb_ld(&bar[XB_TOPGEN]) == tg, bar);
            __builtin_amdgcn_fence(__ATOMIC_ACQUIRE, "agent");
            xb_add(&bar[XB_XGEN(b.x)], 1u);
            asm volatile("s_waitcnt vmcnt(0)" ::: "memory");
        } else {
            XB_SPIN(xb_ld(&bar[XB_XGEN(b.x)]) == gen, bar);
            __builtin_amdgcn_fence(__ATOMIC_ACQUIRE, "agent");
            asm volatile("s_waitcnt vmcnt(0)" ::: "memory");
        }
    }
    __syncthreads();
}

using pg8::Unit;
__device__ __forceinline__ int dimperm(int i) { const int fq = i >> 3, n = (i >> 2) & 1, j = i & 3, pi = 4 * fq + j; return (pi < 8 ? pi : 8 + pi) + 8 * n; }

struct EpiWin {
    static constexpr bool PERM = true;
    bf16_t* P; bf16_t* Zt; bf16_t* ZtC; const float* nqg; const float* nkg; const float* dqg; const float* dkg; const f32x2* rope;
    __device__ __forceinline__ void operator()(const f32x4 (&acc)[2][2][4][2], const Unit& u, int wr, int wc, int fr_, int fq_) const {
        int fr = fr_, fq = fq_; asm volatile("" : "+v"(fr), "+v"(fq));
        const int pn = u.pn, row0 = u.pm * 256 + wr * 64 + fr;
        if (pn >= 9) {
            const int gma = 128 * (pn - 9) + 16 * wc + 4 * fq;
#pragma unroll
            for (int ai = 0; ai < 2; ++ai)
#pragma unroll
                for (int m = 0; m < 4; ++m) {
                    const int row = row0 + 128 * ai + 16 * m;
#pragma unroll
                    for (int bj = 0; bj < 2; ++bj)
#pragma unroll
                        for (int n = 0; n < 2; ++n) {
                            const f32x4 v = acc[ai][bj][m][n]; const unsigned w0 = cvtpk(v[0], v[1]), w1 = cvtpk(v[2], v[3]);
                            const int gm = gma + 64 * bj + 2 * n;
                            if (row < NLAT) {
                                const int b = row >> 13, nn = row & 8191, n1 = nn >> 6, n2 = nn & 63;
                                const size_t r0 = ((((size_t)(b * 16 + (gm >> 4)) * 4 + (n2 >> 4)) * 16 + (gm & 15)) * 16 + (n2 & 15));
                                *(unsigned*)(Zt + r0 * 256 + 2 * n1) = w0;
                                *(unsigned*)(Zt + (r0 + 16) * 256 + 2 * n1) = w1;
                            } else {
                                const int rc = row - NLAT, b = rc >> 8, nn = rc & 255;
                                *(unsigned*)(ZtC + ((size_t)(b * 256 + gm)) * 512 + 2 * nn) = w0;
                                *(unsigned*)(ZtC + ((size_t)(b * 256 + gm + 1)) * 512 + 2 * nn) = w1;
                            }
                        }
                }
            return;
        }
        const int colb = 256 * pn + 64 * wc + 8 * fq;
        if (pn == 4 || pn == 5 || pn == 8) {
#pragma unroll
            for (int ai = 0; ai < 2; ++ai)
#pragma unroll
                for (int m = 0; m < 4; ++m) { bf16_t* rowp = P + (size_t)(row0 + 128 * ai + 16 * m) * PP + colb;
#pragma unroll
                    for (int bj = 0; bj < 2; ++bj) { const f32x4 v0 = acc[ai][bj][m][0], v1 = acc[ai][bj][m][1]; u32x4 w; w.x = cvtpk(v0[0], v0[1]); w.y = cvtpk(v0[2], v0[3]); w.z = cvtpk(v1[0], v1[1]); w.w = cvtpk(v1[2], v1[3]);
                        *(u32x4*)(rowp + 32 * bj) = w; } }
            return;
        }
        if (pn < 4) {
            const bool isq = pn < 2; const float* gp = (isq ? nqg : nkg) + 8 * fq;
            const float osc = isq ? 0.125f * LOG2E : 1.0f;
            f32x4 gv[2][2];
#pragma unroll
            for (int bj = 0; bj < 2; ++bj)
#pragma unroll
                for (int n = 0; n < 2; ++n) gv[bj][n] = *(const f32x4*)(gp + 32 * bj + 4 * n) * osc;
#pragma unroll
            for (int ai = 0; ai < 2; ++ai)
#pragma unroll
                for (int m = 0; m < 4; ++m) {
                    float ss = 0.f;
#pragma unroll
                    for (int bj = 0; bj < 2; ++bj)
#pragma unroll
                        for (int n = 0; n < 2; ++n) { const f32x4 v = acc[ai][bj][m][n]; ss += (v[0] * v[0] + v[1] * v[1]) + (v[2] * v[2] + v[3] * v[3]); }
                    ss += SWZ_XOR(ss, 16); ss = sum_xor32(ss);
                    const float rstd = __builtin_amdgcn_rsqf(ss * (1.f / 64.f) + EPS);
                    bf16_t* rowp = P + (size_t)(row0 + 128 * ai + 16 * m) * PP + colb;
#pragma unroll
                    for (int bj = 0; bj < 2; ++bj) { const f32x4 v0 = acc[ai][bj][m][0] * rstd * gv[bj][0], v1 = acc[ai][bj][m][1] * rstd * gv[bj][1];
                        u32x4 w; w.x = cvtpk(v0[0], v0[1]); w.y = cvtpk(v0[2], v0[3]); w.z = cvtpk(v1[0], v1[1]); w.w = cvtpk(v1[2], v1[3]);
                        *(u32x4*)(rowp + 32 * bj) = w; }
                }
            return;
        }
        {
            const bool isq = pn == 6; const float* gp = isq ? dqg : dkg;
            const float osc = isq ? 0.17677669529663687f * LOG2E : 1.0f;
            const bool lat = u.pm < 64;
            f32x4 gv[2];
#pragma unroll
            for (int n = 0; n < 2; ++n)
#pragma unroll
                for (int j = 0; j < 4; ++j) gv[n][j] = gp[dimperm(8 * fq + 4 * n + j)];
#pragma unroll
            for (int ai = 0; ai < 2; ++ai)
#pragma unroll
                for (int m = 0; m < 4; ++m) {
                    const int row = row0 + 128 * ai + 16 * m;
                    f32x2 cs[4];
                    if (lat) { const int gr = (row >> 6) & 127, gc = row & 63; const int pos = (fq < 2) ? gr : gc;
#pragma unroll
                        for (int j = 0; j < 4; ++j) cs[j] = rope[pos * 8 + ((4 * fq + j) & 7)]; }
                    else {
#pragma unroll
                        for (int j = 0; j < 4; ++j) cs[j] = (f32x2){1.f, 0.f}; }
                    bf16_t* rowp = P + (size_t)row * PP + colb;
#pragma unroll
                    for (int bj = 0; bj < 2; ++bj) {
                        const f32x4 a0 = acc[ai][bj][m][0], a1 = acc[ai][bj][m][1];
                        float ss = (a0[0] * a0[0] + a0[1] * a0[1]) + (a0[2] * a0[2] + a0[3] * a0[3]) + (a1[0] * a1[0] + a1[1] * a1[1]) + (a1[2] * a1[2] + a1[3] * a1[3]);
                        ss += SWZ_XOR(ss, 16); ss = sum_xor32(ss);
                        const float rstd = __builtin_amdgcn_rsqf(ss * (1.f / 32.f) + EPS);
                        const f32x4 x1 = a0 * rstd * gv[0], x2 = a1 * rstd * gv[1];
                        f32x4 y1, y2;
#pragma unroll
                        for (int j = 0; j < 4; ++j) { y1[j] = (x1[j] * cs[j].x - x2[j] * cs[j].y) * osc; y2[j] = (x1[j] * cs[j].y + x2[j] * cs[j].x) * osc; }
                        u32x4 w; w.x = cvtpk(y1[0], y1[1]); w.y = cvtpk(y1[2], y1[3]); w.z = cvtpk(y2[0], y2[1]); w.w = cvtpk(y2[2], y2[3]);
                        *(u32x4*)(rowp + 32 * bj) = w;
                    }
                }
        }
    }
};

struct EpiZ {
    static constexpr bool PERM = true;
    bf16_t* Zt; bf16_t* ZtC;
    __device__ __forceinline__ void operator()(const f32x4 (&acc)[2][2][4][2], const Unit& u, int wr, int wc, int fr_, int fq_) const {
        int fr = fr_, fq = fq_; asm volatile("" : "+v"(fr), "+v"(fq));
        const int gma = 128 * u.pn + 16 * wc + 4 * fq;
        if (u.pm < 64) {
            const int b = u.pm >> 5, tp = u.pm & 31, n1b = 8 * (tp >> 1), n2 = 32 * (tp & 1) + 16 * wr + fr;
#pragma unroll
            for (int bj = 0; bj < 2; ++bj)
#pragma unroll
                for (int n = 0; n < 2; ++n)
#pragma unroll
                    for (int p = 0; p < 2; ++p) {
                        const int gm = gma + 64 * bj + 2 * n + p;
                        const size_t r0 = ((((size_t)(b * 16 + (gm >> 4)) * 4 + (n2 >> 4)) * 16 + (gm & 15)) * 16 + (n2 & 15));
#pragma unroll
                        for (int ai = 0; ai < 2; ++ai) { u32x4 w;
#pragma unroll
                            for (int m = 0; m < 4; ++m) w[m] = cvtpk(acc[ai][bj][m][n][2 * p], acc[ai][bj][m][n][2 * p + 1]);
                            *(u32x4*)(Zt + r0 * 256 + 2 * (n1b + 4 * ai)) = w; }
                    }
        } else {
#pragma unroll
            for (int ai = 0; ai < 2; ++ai)
#pragma unroll
                for (int m = 0; m < 4; ++m) {
                    const int idx = 32 * (u.pm & 1) + 64 * (4 * ai + m) + 16 * wr + fr, b = idx >> 8, nn = idx & 255;
#pragma unroll
                    for (int bj = 0; bj < 2; ++bj)
#pragma unroll
                        for (int n = 0; n < 2; ++n)
#pragma unroll
                            for (int p = 0; p < 2; ++p) { const int gm = gma + 64 * bj + 2 * n + p;
                                *(unsigned*)(ZtC + ((size_t)(b * 256 + gm)) * 512 + 2 * nn) = cvtpk(acc[ai][bj][m][n][2 * p], acc[ai][bj][m][n][2 * p + 1]); }
                }
        }
    }
};

struct EpiRes {
    static constexpr bool PERM = false;
    const float* base_lat; float* out_lat; const float* base_ctx; float* out_ctx; const float* gate; float* part;
    __device__ __forceinline__ void operator()(const f32x4 (&acc)[2][2][4][2], const Unit& u, int wr, int wc, int fr_, int fq_) const {
        int fr = fr_, fq = fq_; asm volatile("" : "+v"(fr), "+v"(fq));
        const int v = u.pm < 32 ? 0 : (u.pm < 64 ? 1 : 2);
        const float* bp; float* op; int row0;
        if (u.pm < 64) { bp = base_lat; op = out_lat; row0 = u.pm * 256 + wr * 64 + fr; } else { bp = base_ctx; op = out_ctx; row0 = (u.pm - 64) * 256 + wr * 64 + fr; }
        const int col0 = u.pn * 256 + wc * 32 + 4 * fq;
        f32x4 gv[2][2];
#pragma unroll
        for (int bj = 0; bj < 2; ++bj)
#pragma unroll
            for (int n = 0; n < 2; ++n) gv[bj][n] = *(const f32x4*)(gate + v * 6144 + col0 + 128 * bj + 16 * n);
#pragma unroll
        for (int ai = 0; ai < 2; ++ai)
#pragma unroll
            for (int m = 0; m < 4; ++m) { const size_t off = (size_t)(row0 + 128 * ai + 16 * m) * DM + col0;
#pragma unroll
                for (int bj = 0; bj < 2; ++bj)
#pragma unroll
                    for (int n = 0; n < 2; ++n) {
                        if (part) { *(f32x4*)(part + (size_t)u.kc * (512 * DM) + off + 128 * bj + 16 * n) = gv[bj][n] * acc[ai][bj][m][n]; }
                        else { const f32x4 bs = *(const f32x4*)(bp + off + 128 * bj + 16 * n); *(f32x4*)(op + off + 128 * bj + 16 * n) = bs + gv[bj][n] * acc[ai][bj][m][n]; } }
                if (m & 1) asm volatile("" ::: "memory"); }
    }
};

__device__ __forceinline__ float dpp_shr1(float v) { return __builtin_bit_cast(float, __builtin_amdgcn_update_dpp(0, __builtin_bit_cast(int, v), 0x111, 0xf, 0xf, true)); }
__device__ __forceinline__ float dpp_shl1(float v) { return __builtin_bit_cast(float, __builtin_amdgcn_update_dpp(0, __builtin_bit_cast(int, v), 0x101, 0xf, 0xf, true)); }

struct EpiUp {
    static constexpr bool PERM = true;
    bf16_t* A2; const float* cw; const float* cb; int Mrows;
    __device__ __forceinline__ void operator()(const f32x4 (&acc)[2][2][4][2], const Unit& u, int wr, int wc, int fr_, int fq_) const {
        int fr = fr_, fq = fq_; asm volatile("" : "+v"(fr), "+v"(fq));
        const int T0 = 252 * u.pm, tokb = T0 - 1 + 126 * wr + 8 * fr;
        const int jg0 = 128 * u.pn + 32 * wc + 8 * fq;
        const int lo = T0 + 126 * wr, hiT = (lo + 126 < Mrows) ? lo + 126 : Mrows;
#pragma unroll
        for (int n = 0; n < 2; ++n) {
            const int jc = jg0 + 4 * n;
            const f32x4 g0 = *(const f32x4*)(cw + jc), g1 = *(const f32x4*)(cw + 2 * DFF + jc), g2 = *(const f32x4*)(cw + 4 * DFF + jc), gb = *(const f32x4*)(cb + jc);
            const f32x4 v0 = *(const f32x4*)(cw + DFF + jc), v1 = *(const f32x4*)(cw + 3 * DFF + jc), v2 = *(const f32x4*)(cw + 5 * DFF + jc), vb = *(const f32x4*)(cb + DFF + jc);
            f32x4 gprev, gnext, vprev, vnext;
#pragma unroll
            for (int j = 0; j < 4; ++j) { gprev[j] = dpp_shr1(acc[1][0][3][n][j]); gnext[j] = dpp_shl1(acc[0][0][0][n][j]); vprev[j] = dpp_shr1(acc[1][1][3][n][j]); vnext[j] = dpp_shl1(acc[0][1][0][n][j]); }
#pragma unroll
            for (int i8 = 0; i8 < 8; ++i8) {
                const int tok = tokb + i8; const int msk = tok < NLAT ? 8191 : 255;
                const bool first = (tok & msk) == 0, lastt = ((tok + 1) & msk) == 0;
                const f32x4 gc = acc[i8 >> 2][0][i8 & 3][n], vc = acc[i8 >> 2][1][i8 & 3][n];
                f32x4 gp = i8 > 0 ? acc[(i8 - 1) >> 2][0][(i8 - 1) & 3][n] : gprev, gn = i8 < 7 ? acc[(i8 + 1) >> 2][0][(i8 + 1) & 3][n] : gnext;
                f32x4 vp = i8 > 0 ? acc[(i8 - 1) >> 2][1][(i8 - 1) & 3][n] : vprev, vn = i8 < 7 ? acc[(i8 + 1) >> 2][1][(i8 + 1) & 3][n] : vnext;
                if (first) { gp = (f32x4){0.f, 0.f, 0.f, 0.f}; vp = gp; }
                if (lastt) { gn = (f32x4){0.f, 0.f, 0.f, 0.f}; vn = gn; }
                const f32x4 cg = g0 * gp + g1 * gc + g2 * gn + gb, cv = v0 * vp + v1 * vc + v2 * vn + vb;
                f32x4 r;
#pragma unroll
                for (int j = 0; j < 4; ++j) r[j] = cg[j] * __builtin_amdgcn_rcpf(1.f + __builtin_amdgcn_exp2f(-LOG2E * cg[j])) * cv[j];
                if (tok >= lo && tok < hiT) { u32x2 w; w.x = cvtpk(r[0], r[1]); w.y = cvtpk(r[2], r[3]); *(u32x2*)(A2 + (size_t)tok * DFF + jc) = w; }
            }
        }
    }
};

struct EpiF1 {
    static constexpr bool PERM = true;
    bf16_t* A2t; const f32x2* tw;
    __device__ __forceinline__ void operator()(const f32x4 (&acc)[2][2][4][2], const Unit& u, int wr, int wc, int fr_, int fq_) const {
        int fr = fr_, fq = fq_; asm volatile("" : "+v"(fr), "+v"(fq));
        const int pn = u.pn, n2hi = pn & 3, gmhi = (pn >> 2) & 15, b = pn >> 6;
        const int n2b = 16 * n2hi + 8 * (fq & 1);
#pragma unroll
        for (int m = 0; m < 4; ++m) {
            const int k1 = 64 * wr + 16 * m + fr, k1grp = k1 >> 2, k1lo = k1 & 3;
#pragma unroll
            for (int n = 0; n < 2; ++n) {
                f32x2 t[4];
#pragma unroll
                for (int j = 0; j < 4; ++j) t[j] = tw[(k1 * (n2b + 4 * n + j)) & 8191];
#pragma unroll
                for (int bj = 0; bj < 2; ++bj) {
                    const int gm = 16 * gmhi + 8 * bj + 2 * wc + (fq >> 1);
                    const f32x4 ar = acc[0][bj][m][n], ai = acc[1][bj][m][n];
                    u32x4 w;
#pragma unroll
                    for (int j = 0; j < 4; ++j) { const float re = ar[j] * t[j].x + ai[j] * t[j].y, im = ai[j] * t[j].x - ar[j] * t[j].y; w[j] = cvtpk(re, im); }
                    *(u32x4*)(A2t + ((size_t)(k1grp * 512 + b * 256 + gm)) * 512 + (k1lo * 64 + n2b + 4 * n) * 2) = w;
                }
                asm volatile("" ::: "memory");
            }
        }
    }
};

struct EpiF2 {
    static constexpr bool PERM = true;
    bf16_t* Y; int mode;
    __device__ __forceinline__ void operator()(const f32x4 (&acc)[2][2][4][2], const Unit& u, int wr, int wc, int fr_, int fq_) const {
        int fr = fr_, fq = fq_; asm volatile("" : "+v"(fr), "+v"(fq));
#pragma unroll
        for (int ai = 0; ai < 2; ++ai)
#pragma unroll
            for (int m = 0; m < 4; ++m) {
                int row;
                if (mode == 0) { const int k1grp = u.pn >> 1, b = u.pn & 1, k = 4 * k1grp + 2 * ai + wr + 128 * (16 * m + fr); row = b * SEQ + k; }
                else row = NLAT + 256 * u.pn + 128 * ai + 64 * wr + 16 * m + fr;
                bf16_t* rowp = Y + (size_t)row * DM + 768 + 32 * wc + 8 * fq;
#pragma unroll
                for (int bj = 0; bj < 2; ++bj) { const f32x4 v0 = acc[ai][bj][m][0], v1 = acc[ai][bj][m][1]; u32x4 w; w.x = cvtpk(v0[0], v0[1]); w.y = cvtpk(v0[2], v0[3]); w.z = cvtpk(v1[0], v1[1]); w.w = cvtpk(v1[2], v1[3]);
                    *(u32x4*)(rowp + 128 * bj) = w; }
            }
    }
};
__device__ __forceinline__ int crow(int r, int hi) { return (r & 3) + 8 * (r >> 2) + 4 * hi; }
typedef short v4i16_t __attribute__((ext_vector_type(4)));
__device__ __forceinline__ bf16x8 vtr2(const LAS unsigned char* p) {
    const s16x4 lo = __builtin_bit_cast(s16x4, __builtin_amdgcn_ds_read_tr16_b64_v4i16((LAS v4i16_t*)p));
    const s16x4 hi = __builtin_bit_cast(s16x4, __builtin_amdgcn_ds_read_tr16_b64_v4i16((LAS v4i16_t*)(p + 1024)));
    return (bf16x8){lo[0], lo[1], lo[2], lo[3], hi[0], hi[1], hi[2], hi[3]};
}
__device__ __forceinline__ int vsub_off(int key, int dch) { return ((key >> 3) * 2 + (dch >> 2)) * 512 + (key & 7) * 64 + (dch & 3) * 16; }

template <bool LOCAL>
__device__ __forceinline__ void na_tile(LAS unsigned char* vl, const LAS float* brow, const bf16_t* __restrict__ P, int krn, bool more, int h, int lane, int q32, int hi, int trb,
                                        const bf16x8 (&qf)[2][4], const unsigned (&mk)[2], f32x16 (&o)[2][2], float (&lsum)[2]) {
    LAS unsigned char* kl = vl + 8192;
    asm volatile("s_waitcnt vmcnt(8)" ::: "memory");
    bf16x8 kf[2][4];
#pragma unroll
    for (int kb = 0; kb < 2; ++kb)
#pragma unroll
        for (int d0 = 0; d0 < 4; ++d0) { const int key = 32 * kb + q32; kf[kb][d0] = *(const LAS bf16x8*)(kl + key * 128 + (((2 * d0 + hi) ^ ((key >> 1) & 7)) * 16)); }
    f32x16 s[2][2];
#pragma unroll
    for (int qb = 0; qb < 2; ++qb)
#pragma unroll
        for (int kb = 0; kb < 2; ++kb) {
            if (LOCAL) { const LAS float* bp = brow + (4 * hi - (32 * qb + q32) + 15) + 32 * kb;
#pragma unroll
                for (int e = 0; e < 16; ++e) s[qb][kb][e] = bp[(e & 3) + 8 * (e >> 2)]; }
            else {
#pragma unroll
                for (int e = 0; e < 16; ++e) s[qb][kb][e] = 0.f; }
#pragma unroll
            for (int d0 = 0; d0 < 4; ++d0) s[qb][kb] = __builtin_amdgcn_mfma_f32_32x32x16_bf16(kf[kb][d0], qf[qb][d0], s[qb][kb], 0, 0, 0);
        }
    if (more) {
        const int kk = lane >> 3, kc = (lane & 7) ^ ((kk >> 1) & 7);
#pragma unroll
        for (int i = 0; i < 8; ++i)
            __builtin_amdgcn_global_load_lds((const unsigned*)(P + (size_t)(krn + 8 * i + kk) * PP + NAK0 + 64 * h + 8 * (kc ^ ((4 * i) & 7))), (LAS unsigned*)(kl + 1024 * i), 16, 0, 0);
    }
#pragma unroll
    for (int qb = 0; qb < 2; ++qb) {
        bf16x8 pf[4];
#pragma unroll
        for (int kb = 0; kb < 2; ++kb) {
            float pe[16];
#pragma unroll
            for (int e = 0; e < 16; ++e) { float p = __builtin_amdgcn_exp2f(s[qb][kb][e]);
                if (LOCAL) { const int msk = ((int)(mk[qb] << (31 - (16 * kb + e)))) >> 31; p = __builtin_bit_cast(float, __builtin_bit_cast(int, p) & msk); }
                pe[e] = p; lsum[qb] += p; }
#pragma unroll
            for (int hf = 0; hf < 2; ++hf) { u32x4 w; w.x = cvtpk(pe[8 * hf + 0], pe[8 * hf + 1]); w.y = cvtpk(pe[8 * hf + 2], pe[8 * hf + 3]); w.z = cvtpk(pe[8 * hf + 4], pe[8 * hf + 5]); w.w = cvtpk(pe[8 * hf + 6], pe[8 * hf + 7]);
                pf[2 * kb + hf] = __builtin_bit_cast(bf16x8, w); }
        }
        if (qb == 0) { if (more) asm volatile("s_waitcnt vmcnt(8)" ::: "memory"); else asm volatile("s_waitcnt vmcnt(0)" ::: "memory"); }
#pragma unroll
        for (int d0 = 0; d0 < 2; ++d0) { bf16x8 vf[4];
#pragma unroll
            for (int ks = 0; ks < 4; ++ks) vf[ks] = vtr2(vl + trb + (4 * ks + d0) * 512);
#pragma unroll
            for (int ks = 0; ks < 4; ++ks) o[qb][d0] = __builtin_amdgcn_mfma_f32_32x32x16_bf16(vf[ks], pf[ks], o[qb][d0], 0, 0, 0); }
    }
    if (more) {
        asm volatile("s_waitcnt lgkmcnt(0)" ::: "memory");
#pragma unroll
        for (int i = 0; i < 8; ++i)
            __builtin_amdgcn_global_load_lds((const unsigned*)(P + (size_t)(krn + 8 * i + ((lane & 31) >> 2)) * PP + NAV0 + 64 * h + 32 * (lane >> 5) + 8 * (lane & 3)), (LAS unsigned*)(vl + 1024 * i), 16, 0, 0);
    }
}
__device__ __forceinline__ void na_unit(LAS unsigned char* lds, const bf16_t* __restrict__ P, bf16_t* __restrict__ Y, const float* __restrict__ rpb, int qrow0, int b, int r, int wid, int lane_in) {
    int lane = lane_in; asm volatile("" : "+v"(lane));
    const int h = wid, q32 = lane & 31, hi = lane >> 5;
    LAS unsigned char* vl = lds + wid * 17408;
    LAS float* btab = (LAS float*)(vl + 16384);
    int rs = 0;
    unsigned mk[2] = {0u, 0u};
    if (r >= 0) {
        rs = r - 4; rs = rs < 0 ? 0 : (rs > 120 ? 120 : rs);
#pragma unroll
        for (int i = 0; i < 4; ++i) { const int e = lane + 64 * i, kt = e >> 5, rel = e & 31, dr = rs + kt - r + 7; btab[e] = rel < 31 ? rpb[(h * 15 + dr) * 31 + rel] * LOG2E : 0.f; }
#pragma unroll
        for (int qb = 0; qb < 2; ++qb) { const int c = 32 * qb + q32; int cs = c - 8; cs = cs < 0 ? 0 : (cs > 48 ? 48 : cs);
#pragma unroll
            for (int bit = 0; bit < 32; ++bit) { const int kc = 32 * (bit >> 4) + crow(bit & 15, hi); if ((unsigned)(kc - cs) < 16u) mk[qb] |= (1u << bit); } }
    }
    bf16x8 qf[2][4];
#pragma unroll
    for (int qb = 0; qb < 2; ++qb)
#pragma unroll
        for (int d0 = 0; d0 < 4; ++d0) qf[qb][d0] = *(const bf16x8*)(P + (size_t)(qrow0 + 32 * qb + q32) * PP + NAQ0 + 64 * h + 16 * d0 + 8 * hi);
    f32x16 o[2][2]; float lsum[2] = {0.f, 0.f};
#pragma unroll
    for (int a = 0; a < 2; ++a)
#pragma unroll
        for (int d = 0; d < 2; ++d)
#pragma unroll
            for (int e = 0; e < 16; ++e) o[a][d][e] = 0.f;
    const int trb = (4 * hi + ((lane & 15) >> 2)) * 64 + (((lane >> 4) & 1) * 16 + (lane & 3) * 4) * 2;
    const int nloc = (r >= 0) ? 8 : 0, ntiles = nloc + 4;
#define NA_ROW0(t_) ((t_) < nloc ? b * SEQ + 64 * (rs + (t_)) : NLAT + b * CTXL + 64 * ((t_) - nloc))
    {
        const int kr0 = NA_ROW0(0); const int kk = lane >> 3, kc = (lane & 7) ^ ((kk >> 1) & 7);
#pragma unroll
        for (int i = 0; i < 8; ++i)
            __builtin_amdgcn_global_load_lds((const unsigned*)(P + (size_t)(kr0 + 8 * i + kk) * PP + NAK0 + 64 * h + 8 * (kc ^ ((4 * i) & 7))), (LAS unsigned*)(vl + 8192 + 1024 * i), 16, 0, 0);
#pragma unroll
        for (int i = 0; i < 8; ++i)
            __builtin_amdgcn_global_load_lds((const unsigned*)(P + (size_t)(kr0 + 8 * i + ((lane & 31) >> 2)) * PP + NAV0 + 64 * h + 32 * (lane >> 5) + 8 * (lane & 3)), (LAS unsigned*)(vl + 1024 * i), 16, 0, 0);
    }
    for (int t = 0; t < nloc; ++t) na_tile<true>(vl, btab + t * 32, P, NA_ROW0(t + 1), true, h, lane, q32, hi, trb, qf, mk, o, lsum);
    for (int t = nloc; t < ntiles; ++t) na_tile<false>(vl, btab, P, NA_ROW0(t + 1), t + 1 < ntiles, h, lane, q32, hi, trb, qf, mk, o, lsum);
#undef NA_ROW0
#pragma unroll
    for (int qb = 0; qb < 2; ++qb) {
        const float l = sum_xor32(lsum[qb]); const float rl = 1.f / l;
        bf16_t* yp = Y + (size_t)(qrow0 + 32 * qb + q32) * DM + 64 * h + 4 * hi;
#pragma unroll
        for (int d0 = 0; d0 < 2; ++d0)
#pragma unroll
            for (int g4 = 0; g4 < 4; ++g4) { u32x2 w; w.x = cvtpk(o[qb][d0][4 * g4] * rl, o[qb][d0][4 * g4 + 1] * rl); w.y = cvtpk(o[qb][d0][4 * g4 + 2] * rl, o[qb][d0][4 * g4 + 3] * rl);
                *(u32x2*)(yp + 32 * d0 + 8 * g4) = w; }
    }
}

#define DU_ROW(t_) ((size_t)(((t_) < 128 ? b * SEQ + 64 * (t_) : NLAT + b * CTXL + 64 * ((t_) - 128)) + skey) * PP)
#define DU_TILE(BUF) do { \
        bf16x8 p1[4], p2[4]; \
        _Pragma("unroll") for (int c = 0; c < 2; ++c) { \
            _Pragma("unroll") for (int kb = 0; kb < 2; ++kb) { \
                const int key = 32 * kb + q32; \
                f32x16 s; \
                _Pragma("unroll") for (int e = 0; e < 16; ++e) s[e] = 0.f; \
                _Pragma("unroll") for (int d0 = 0; d0 < 2; ++d0) { const int ch = 4 * c + 2 * d0 + hi; const bf16x8 kf = *(const LAS bf16x8*)((BUF) + key * 128 + ((ch ^ ((key >> 1) & 7)) * 16)); \
                    s = __builtin_amdgcn_mfma_f32_32x32x16_bf16(kf, qf[c][d0], s, 0, 0, 0); } \
                float pe[16]; float ls = 0.f; \
                _Pragma("unroll") for (int e = 0; e < 16; ++e) { pe[e] = __builtin_amdgcn_exp2f(s[e]); ls += pe[e]; } \
                if (c == 0) l1 += ls; else l2 += ls; \
                _Pragma("unroll") for (int hf = 0; hf < 2; ++hf) { u32x4 w; w.x = cvtpk(pe[8 * hf + 0], pe[8 * hf + 1]); w.y = cvtpk(pe[8 * hf + 2], pe[8 * hf + 3]); w.z = cvtpk(pe[8 * hf + 4], pe[8 * hf + 5]); w.w = cvtpk(pe[8 * hf + 6], pe[8 * hf + 7]); \
                    if (c == 0) p1[2 * kb + hf] = __builtin_bit_cast(bf16x8, w); else p2[2 * kb + hf] = __builtin_bit_cast(bf16x8, w); } \
            } \
        } \
        _Pragma("unroll") for (int d0 = 0; d0 < 2; ++d0) \
            _Pragma("unroll") for (int ks = 0; ks < 4; ++ks) { const bf16x8 vf = vtr2((BUF) + trb + (4 * ks + d0) * 512); \
                o1[d0] = __builtin_amdgcn_mfma_f32_32x32x16_bf16(vf, p1[ks], o1[d0], 0, 0, 0); o2[d0] = __builtin_amdgcn_mfma_f32_32x32x16_bf16(vf, p2[ks], o2[d0], 0, 0, 0); } \
    } while (0)
__device__ __forceinline__ void diff_unit(LAS unsigned char* lds, const bf16_t* __restrict__ P, bf16_t* __restrict__ Y, const float* __restrict__ subg, int qrow0, int b, int h, int t0, int t1, float lam, float oscale, int tid_in) {
    int tid = tid_in; asm volatile("" : "+v"(tid));
    const int lane = tid & 63, wid = tid >> 6, q32 = lane & 31, hi = lane >> 5;
    const int qrow = qrow0 + 32 * wid + q32;
    bf16x8 qf[2][2];
#pragma unroll
    for (int c = 0; c < 2; ++c)
#pragma unroll
        for (int d0 = 0; d0 < 2; ++d0) qf[c][d0] = *(const bf16x8*)(P + (size_t)qrow * PP + DQ0 + 64 * h + 32 * c + 16 * d0 + 8 * hi);
    const int trb = 8192 + (4 * hi + ((lane & 15) >> 2)) * 64 + (((lane >> 4) & 1) * 16 + (lane & 3) * 4) * 2;
    f32x16 o1[2], o2[2]; float l1 = 0.f, l2 = 0.f;
#pragma unroll
    for (int d = 0; d < 2; ++d)
#pragma unroll
        for (int e = 0; e < 16; ++e) { o1[d][e] = 0.f; o2[d][e] = 0.f; }
    const int kkey = 8 * wid + (lane >> 3), kch = (lane & 7) ^ ((kkey >> 1) & 7);
    const size_t koff = (size_t)kkey * PP + DK0 + 64 * h + 8 * kch, voff = (size_t)(8 * wid + ((lane & 31) >> 2)) * PP + DV0 + 64 * h + 32 * (lane >> 5) + 8 * (lane & 3);
#define DU_DMA(tt, sl) do { const size_t r_ = (size_t)((tt) < 128 ? b * SEQ + 64 * (tt) : NLAT + b * CTXL + 64 * ((tt) - 128)) * PP; \
        __builtin_amdgcn_global_load_lds((const unsigned*)(P + r_ + koff), (LAS unsigned*)(lds + (sl) * 16384 + wid * 1024), 16, 0, 0); \
        __builtin_amdgcn_global_load_lds((const unsigned*)(P + r_ + voff), (LAS unsigned*)(lds + (sl) * 16384 + 8192 + wid * 1024), 16, 0, 0); } while (0)
    DU_DMA(t0, 0); DU_DMA(t0 + 1, 1);
    asm volatile("s_waitcnt vmcnt(2)" ::: "memory"); __builtin_amdgcn_s_barrier(); asm volatile("" ::: "memory");
    int slot = 0;
    for (int t = t0; t < t1; ++t) {
        const int s2 = slot == 0 ? 2 : slot - 1;
        if (t + 2 < t1) DU_DMA(t + 2, s2);
        { LAS unsigned char* buf = lds + slot * 16384; DU_TILE(buf); }
        if (t + 2 < t1) asm volatile("s_waitcnt vmcnt(2)" ::: "memory"); else asm volatile("s_waitcnt vmcnt(0)" ::: "memory");
        __builtin_amdgcn_s_barrier(); asm volatile("" ::: "memory");
        slot = slot == 2 ? 0 : slot + 1;
    }
#undef DU_DMA
    l1 = sum_xor32(l1); l2 = sum_xor32(l2);
    const float r1 = 1.f / l1, r2 = lam / l2;
    float ss = 0.f;
#pragma unroll
    for (int d0 = 0; d0 < 2; ++d0)
#pragma unroll
        for (int e = 0; e < 16; ++e) { const float v = o1[d0][e] * r1 - o2[d0][e] * r2; o1[d0][e] = v; ss += v * v; }
    ss = sum_xor32(ss);
    const float rstd = __builtin_amdgcn_rsqf(ss * (1.f / 64.f) + EPS) * oscale;
    bf16_t* yp = Y + (size_t)qrow * DM + 512 + 64 * h + 4 * hi;
    const float* sg = subg; asm volatile("" : "+s"(sg));
#pragma unroll
    for (int d0 = 0; d0 < 2; ++d0)
#pragma unroll
        for (int g4 = 0; g4 < 4; ++g4) { const f32x4 gg = *(const f32x4*)(sg + 32 * d0 + 8 * g4 + 4 * hi);
            u32x2 w; w.x = cvtpk(o1[d0][4 * g4] * rstd * gg[0], o1[d0][4 * g4 + 1] * rstd * gg[1]); w.y = cvtpk(o1[d0][4 * g4 + 2] * rstd * gg[2], o1[d0][4 * g4 + 3] * rstd * gg[3]);
            *(u32x2*)(yp + 32 * d0 + 8 * g4) = w; }
}
#undef DU_TILE
#undef DU_ROW

__device__ __forceinline__ float fadd_s(float a, float b) { float r; asm("v_add_f32_e32 %0, %1, %2" : "=v"(r) : "v"(a), "v"(b)); return r; }
#define DF_EXP(S0, S1, PF, LSUM) do { \
    _Pragma("unroll") for (int kb_ = 0; kb_ < 2; ++kb_) { float pe_[16]; \
        _Pragma("unroll") for (int e_ = 0; e_ < 16; ++e_) { pe_[e_] = __builtin_amdgcn_exp2f(kb_ == 0 ? S0[e_] : S1[e_]); LSUM += pe_[e_]; asm volatile("" : "+v"(LSUM)); } \
        _Pragma("unroll") for (int hf_ = 0; hf_ < 2; ++hf_) { u32x4 w_; w_.x = cvtpk(pe_[8 * hf_ + 0], pe_[8 * hf_ + 1]); w_.y = cvtpk(pe_[8 * hf_ + 2], pe_[8 * hf_ + 3]); w_.z = cvtpk(pe_[8 * hf_ + 4], pe_[8 * hf_ + 5]); w_.w = cvtpk(pe_[8 * hf_ + 6], pe_[8 * hf_ + 7]); \
            PF[2 * kb_ + hf_] = __builtin_bit_cast(bf16x8, w_); } } } while (0)
#define DF_S2(C, DST0, DST1, KBUF) do { bf16x8 kf_[2][2]; \
    _Pragma("unroll") for (int kb_ = 0; kb_ < 2; ++kb_) _Pragma("unroll") for (int d0_ = 0; d0_ < 2; ++d0_) { const int key_ = 32 * kb_ + q32; \
        kf_[kb_][d0_] = *(const LAS bf16x8*)((KBUF) + key_ * 128 + (((4 * (C) + 2 * d0_ + hi) ^ ((key_ >> 1) & 7)) * 16)); } \
    DST0 = __builtin_amdgcn_mfma_f32_32x32x16_bf16(kf_[0][0], qf[C][0], Z, 0, 0, 0); DST1 = __builtin_amdgcn_mfma_f32_32x32x16_bf16(kf_[1][0], qf[C][0], Z, 0, 0, 0); \
    DST0 = __builtin_amdgcn_mfma_f32_32x32x16_bf16(kf_[0][1], qf[C][1], DST0, 0, 0, 0); DST1 = __builtin_amdgcn_mfma_f32_32x32x16_bf16(kf_[1][1], qf[C][1], DST1, 0, 0, 0); } while (0)
#define DF_PV(O, PF, VBUF) do { bf16x8 vf_[2][4]; \
    _Pragma("unroll") for (int d0_ = 0; d0_ < 2; ++d0_) _Pragma("unroll") for (int ks_ = 0; ks_ < 4; ++ks_) vf_[d0_][ks_] = vtr2((VBUF) + trb + (4 * ks_ + d0_) * 512); \
    _Pragma("unroll") for (int ks_ = 0; ks_ < 4; ++ks_) _Pragma("unroll") for (int d0_ = 0; d0_ < 2; ++d0_) O[d0_] = __builtin_amdgcn_mfma_f32_32x32x16_bf16(vf_[d0_][ks_], PF[ks_], O[d0_], 0, 0, 0); } while (0)
__device__ __forceinline__ void diff_unit2(LAS unsigned char* lds, const bf16_t* __restrict__ P, bf16_t* __restrict__ Y, const float* __restrict__ subg, int qrow0, int b, int h, int t0, int t1, float lam, float oscale, int tid_in) {
    int tid = tid_in; asm volatile("" : "+v"(tid));
    const int lane = tid & 63, wid = tid >> 6, q32 = lane & 31, hi = lane >> 5;
    const int qrow = qrow0 + 32 * wid + q32;
    bf16x8 qf[2][2];
#pragma unroll
    for (int c = 0; c < 2; ++c)
#pragma unroll
        for (int d0 = 0; d0 < 2; ++d0) qf[c][d0] = *(const bf16x8*)(P + (size_t)qrow * PP + DQ0 + 64 * h + 32 * c + 16 * d0 + 8 * hi);
    const int skey = tid >> 3, sch = tid & 7;
    const int kdst = skey * 128 + ((sch ^ ((skey >> 1) & 7)) * 16), vdst = 16384 + vsub_off(skey, sch);
    const int trb = (4 * hi + ((lane & 15) >> 2)) * 64 + (((lane >> 4) & 1) * 16 + (lane & 3) * 4) * 2;
    f32x16 Z; { float z0 = 0.f; asm volatile("" : "+v"(z0));
#pragma unroll
    for (int e = 0; e < 16; ++e) Z[e] = z0; }
    asm volatile("" : "+v"(Z));
    f32x16 o1[2], o2[2]; float l1 = 0.f, l2 = 0.f;
#pragma unroll
    for (int d = 0; d < 2; ++d) { o1[d] = Z; o2[d] = Z; }
    const bf16_t* kg = P + DK0 + 64 * h + 8 * sch; const bf16_t* vg = P + DV0 + 64 * h + 8 * sch;
#define DF_ROW(t_) ((size_t)(((t_) < 128 ? b * SEQ + 64 * (t_) : NLAT + b * CTXL + 64 * ((t_) - 128)) + skey) * PP)
    u32x4 rk, rv;
    rk = *(const u32x4*)(kg + DF_ROW(t0)); rv = *(const u32x4*)(vg + DF_ROW(t0));
    *(LAS u32x4*)(lds + kdst) = rk; *(LAS u32x4*)(lds + vdst) = rv;
    rk = *(const u32x4*)(kg + DF_ROW(t0 + 1));
    *(LAS u32x4*)(lds + 8192 + kdst) = rk;
    __syncthreads();
    f32x16 sA0, sA1, sB0, sB1; bf16x8 p1[4], p2[4];
    DF_S2(0, sA0, sA1, lds); DF_S2(1, sB0, sB1, lds);
    __syncthreads();
    DF_EXP(sA0, sA1, p1, l1);
    for (int t = t0; t < t1; ++t) {
        const int it = t - t0; const bool more = (t + 1 < t1);
        LAS unsigned char* kb1 = lds + ((it + 1) & 1) * 8192;
        LAS unsigned char* vb0 = lds + 16384 + (it & 1) * 8192;
        if (t + 2 < t1) rk = *(const u32x4*)(kg + DF_ROW(t + 2));
        if (more) rv = *(const u32x4*)(vg + DF_ROW(t + 1));
        __builtin_amdgcn_sched_barrier(0);
        if (more) { DF_S2(0, sA0, sA1, kb1); }
        DF_PV(o1, p1, vb0);
        DF_EXP(sB0, sB1, p2, l2);
        __builtin_amdgcn_sched_barrier(0);
        DF_PV(o2, p2, vb0);
        if (more) { DF_S2(1, sB0, sB1, kb1); DF_EXP(sA0, sA1, p1, l1); }
        __builtin_amdgcn_sched_barrier(0);
        if (t + 2 < t1) *(LAS u32x4*)(lds + (it & 1) * 8192 + kdst) = rk;
        if (more) *(LAS u32x4*)(lds + ((it + 1) & 1) * 8192 + vdst) = rv;
        __syncthreads();
    }
#undef DF_ROW
    l1 = sum_xor32(l1); l2 = sum_xor32(l2);
    const float r1 = 1.f / l1, r2 = lam / l2;
    float ss = 0.f;
#pragma unroll
    for (int d0 = 0; d0 < 2; ++d0)
#pragma unroll
        for (int e = 0; e < 16; ++e) { const float v = o1[d0][e] * r1 - o2[d0][e] * r2; o1[d0][e] = v; ss += v * v; }
    ss = sum_xor32(ss);
    const float rstd = __builtin_amdgcn_rsqf(ss * (1.f / 64.f) + EPS) * oscale;
    bf16_t* yp = Y + (size_t)qrow * DM + 512 + 64 * h + 4 * hi;
    const float* sg = subg; asm volatile("" : "+s"(sg));
#pragma unroll
    for (int d0 = 0; d0 < 2; ++d0)
#pragma unroll
        for (int g4 = 0; g4 < 4; ++g4) { const f32x4 gg = *(const f32x4*)(sg + 32 * d0 + 8 * g4 + 4 * hi);
            u32x2 w; w.x = cvtpk(o1[d0][4 * g4] * rstd * gg[0], o1[d0][4 * g4 + 1] * rstd * gg[1]); w.y = cvtpk(o1[d0][4 * g4 + 2] * rstd * gg[2], o1[d0][4 * g4 + 3] * rstd * gg[3]);
            *(u32x2*)(yp + 32 * d0 + 8 * g4) = w; }
}
constexpr size_t MiB = 1u << 20;
constexpr size_t WS_MOD = 0, WS_LAM = 160 * 1024, WS_BAR = 176 * 1024, WS_ROPE = 192 * 1024, WS_TW = 256 * 1024, WS_M1 = 384 * 1024, WS_M2 = 512 * 1024, WS_MC = 768 * 1024;
constexpr size_t WS_W = 1 * MiB, W_LAYER = 24 * MiB, WO_IN = 0, WO_OUT = 5632 * 1024, WO_UP = WO_OUT + 2 * MiB, WO_DN = WO_UP + 11 * MiB;
constexpr size_t WS_XC = 49 * MiB, WS_XN = 51 * MiB, WS_P = 85 * MiB, WS_ZT = 160 * MiB, WS_ZTC = 176 * MiB, WS_A2T = 177 * MiB, WS_Y = 193 * MiB, WS_A2 = 85 * MiB, WS_PART = 228 * MiB, WS_END = 252 * MiB;
static_assert(WO_DN + (size_t)1024 * 2816 * 2 <= W_LAYER, "weights");
static_assert(WS_XN + (size_t)(1 + MT + 256) * DM * 2 <= WS_P && WS_P + (size_t)MT * PP * 2 <= WS_ZT && WS_A2 + (size_t)MT * DFF * 2 <= WS_Y && WS_Y + (size_t)MT * DM * 2 <= WS_PART && WS_PART + (size_t)11 * 512 * DM * 4 <= WS_END, "ws map");

struct Args { const float* in[22]; float* out; unsigned char* ws; };

__device__ __forceinline__ void tr_item(const float* __restrict__ src, int ld, int k0, int c0, bf16_t* __restrict__ dst, int dK, int r0, bool perm, LAS float* scr, int lane) {
#pragma unroll 8
    for (int i = 0; i < 32; ++i) { const int kk = 2 * i + (lane >> 5); scr[kk * 33 + (lane & 31)] = src[(size_t)(k0 + kk) * ld + c0 + (lane & 31)]; }
    const int c = lane & 7;
#pragma unroll
    for (int j = 0; j < 4; ++j) { const int n = (lane >> 3) + 8 * j; const int sn = perm ? dimperm(n) : n; const LAS float* s = scr + (8 * c) * 33 + sn;
        u32x4 o; o.x = cvtpk(s[0 * 33], s[1 * 33]); o.y = cvtpk(s[2 * 33], s[3 * 33]); o.z = cvtpk(s[4 * 33], s[5 * 33]); o.w = cvtpk(s[6 * 33], s[7 * 33]);
        *(u32x4*)(dst + (size_t)(r0 + n) * dK + k0 + 8 * c) = o; }
}

__device__ __forceinline__ void tr_item64(const float* __restrict__ src, int ld, int k0, int c0, bf16_t* __restrict__ dst, int dK, int ra, int rb, bool perm, LAS float* scr, int lane) {
    f32x4 v[16];
    const float* sp = src + (size_t)(k0 + (lane >> 4)) * ld + c0 + 4 * (lane & 15);
#pragma unroll
    for (int i = 0; i < 16; ++i) v[i] = *(const f32x4*)(sp + (size_t)(4 * i) * ld);
#pragma unroll
    for (int i = 0; i < 16; ++i) { LAS float* w = scr + (4 * i + (lane >> 4)) * 65 + 4 * (lane & 15); w[0] = v[i][0]; w[1] = v[i][1]; w[2] = v[i][2]; w[3] = v[i][3]; }
    const int c = lane & 7;
#pragma unroll
    for (int j = 0; j < 8; ++j) { const int n = (lane >> 3) + 8 * j, i32 = n & 31; const int sn = (n & 32) + (perm ? dimperm(i32) : i32); const LAS float* s = scr + (8 * c) * 65 + sn;
        u32x4 o; o.x = cvtpk(s[0 * 65], s[1 * 65]); o.y = cvtpk(s[2 * 65], s[3 * 65]); o.z = cvtpk(s[4 * 65], s[5 * 65]); o.w = cvtpk(s[6 * 65], s[7 * 65]);
        *(u32x4*)(dst + (size_t)((n < 32 ? ra : rb) + i32) * dK + k0 + 8 * c) = o; }
}

__device__ __forceinline__ float silu_f(float x) { return x / (1.f + __expf(-x)); }

__device__ __forceinline__ void prep_phase(const Args& a, LAS unsigned char* lds, int tid_in, int bx, int G) {
    int tid = tid_in; asm volatile("" : "+v"(tid));
    unsigned char* ws = a.ws;
    const int lane = tid & 63, wave = __builtin_amdgcn_readfirstlane(tid >> 6);
#ifndef REP_PB
#define REP_PB 1
#endif
#ifndef REP_PT
#define REP_PT 1
#endif
#ifndef REP_PX
#define REP_PX 1
#endif
    for (int rp = 0; rp < REP_PB; ++rp) {
    const int nslots = (G == 256) ? 2 : (448 + G - 1) / G;
    for (int slot = 0; slot < nslots; ++slot) {
        int it;
        if (G == 256) { if (bx < 128) it = slot == 0 ? bx : (bx < 64 ? 128 + bx : -1); else it = slot == 0 ? 320 + (bx - 128) : 192 + (bx - 128); }
        else { it = bx + slot * G; if (it >= 448) it = -1; }
        if (it < 0) continue;
        __syncthreads();
        if (it < 192) {
            const int l = it / 96, n0 = 64 * (it % 96);
            LAS float* sv = (LAS float*)lds; LAS float* red = sv + 3072;
            for (int e = tid; e < 3072; e += 512) { const int v = e >> 10, k = e & 1023; sv[e] = silu_f(v < 2 ? a.in[1][v * 1024 + k] : a.in[3][k]); }
            __syncthreads();
            const int cq = tid & 15, kg = tid >> 4;
            f32x4 ac[3] = {{0.f, 0.f, 0.f, 0.f}, {0.f, 0.f, 0.f, 0.f}, {0.f, 0.f, 0.f, 0.f}};
            const float* wp = a.in[4] + (size_t)l * 1024 * 6144 + n0 + 4 * cq;
#pragma unroll 8
            for (int i = 0; i < 32; ++i) { const int k = kg + 32 * i; const f32x4 w = *(const f32x4*)(wp + (size_t)k * 6144); ac[0] += w * sv[k]; ac[1] += w * sv[1024 + k]; ac[2] += w * sv[2048 + k]; }
#pragma unroll
            for (int v = 0; v < 3; ++v)
#pragma unroll
                for (int e = 0; e < 4; ++e) red[(kg * 16 + cq) * 12 + v * 4 + e] = ac[v][e];
            __syncthreads();
            if (tid < 192) { const int v = tid >> 6, n = tid & 63; float s = a.in[5][l * 6144 + n0 + n];
                for (int g = 0; g < 32; ++g) s += red[(g * 16 + (n >> 2)) * 12 + v * 4 + (n & 3)];
                ((float*)(ws + WS_MOD))[(l * 3 + v) * 6144 + n0 + n] = s; }
            asm volatile("s_waitcnt vmcnt(0)" ::: "memory"); __syncthreads();
            if (tid == 0) { __builtin_amdgcn_fence(__ATOMIC_RELEASE, "agent"); asm volatile("s_waitcnt vmcnt(0)" ::: "memory"); xb_add((unsigned*)(ws + WS_BAR) + 3648, 1u); }
        } else if (it < 320) {
            const int q = it - 192, l = q >> 6, g = (q >> 4) & 3, k0 = 64 * (q & 15);
            LAS float* wt = (LAS float*)lds; LAS float* ct = wt + 64 * 65; LAS float* st = ct + 64;
            for (int e = tid; e < 4096; e += 512) { const int k = e >> 6, j = e & 63; wt[k * 65 + j] = a.in[7][((size_t)l * 1024 + k0 + k) * INW + FN0 + 64 * g + j]; }
            if (tid < 64) { ct[tid] = cospif((float)tid / 32.f) * 0.125f; st[tid] = -sinpif((float)tid / 32.f) * 0.125f; }
            __syncthreads();
            bf16_t* dst = (bf16_t*)(ws + WS_W + l * W_LAYER + WO_IN);
            {
                const int k = lane, c = wave & 1, m0 = wave >> 1;
                const float tl = c ? st[lane] : ct[lane];
                float s[16];
#pragma unroll
                for (int i = 0; i < 16; ++i) s[i] = 0.f;
#pragma unroll 4
                for (int j = 0; j < 64; ++j) { const float w = wt[k * 65 + j];
#pragma unroll
                    for (int i = 0; i < 16; ++i) s[i] += w * __builtin_bit_cast(float, __builtin_amdgcn_readlane(__builtin_bit_cast(int, tl), ((m0 + 4 * i) * j) & 63)); }
#pragma unroll
                for (int i = 0; i < 16; ++i) dst[(size_t)(2304 + 128 * g + wave + 8 * i) * 1024 + k0 + k] = f2bf(s[i]);
            }
        } else {
            const int q = it - 320, l = q >> 6, n0 = 16 * (q & 63);
            LAS float* wo = (LAS float*)lds; LAS float* wf = wo + 256 * 20;
            for (int e = tid; e < 4096; e += 512) { const int j = e >> 4, nn = e & 15; wo[j * 20 + nn] = a.in[16][((size_t)l * 1024 + 768 + j) * 1024 + n0 + nn]; }
            const int i = tid & 255, nh = tid >> 8;
            float acc[8];
#pragma unroll
            for (int e = 0; e < 8; ++e) acc[e] = 0.f;
            for (int j0 = 0; j0 < 256; j0 += 32) {
                __syncthreads();
                for (int e = tid; e < 8192; e += 512) { const int ii = e >> 5, jj = e & 31; wf[ii * 33 + jj] = a.in[15][((size_t)l * 256 + ii) * 256 + j0 + jj]; }
                __syncthreads();
                for (int jj = 0; jj < 32; ++jj) { const float w = wf[i * 33 + jj]; const LAS f32x4* wr_ = (const LAS f32x4*)(wo + (j0 + jj) * 20 + 8 * nh);
#pragma unroll
                    for (int e4 = 0; e4 < 2; ++e4) { const f32x4 wv = wr_[e4];
#pragma unroll
                        for (int e = 0; e < 4; ++e) acc[4 * e4 + e] += w * wv[e]; } }
            }
            bf16_t* dst = (bf16_t*)(ws + WS_W + l * W_LAYER + WO_OUT);
#pragma unroll
            for (int e = 0; e < 8; ++e) dst[(size_t)(n0 + 8 * nh + e) * 1024 + 768 + i] = f2bf(acc[e]);
        }
    }
    }
    __syncthreads();
    {
        LAS float* scr = (LAS float*)(lds + wave * 16640);
        const int gw = bx * 8 + wave, NGW = G * 8;
        constexpr int I_IN = 16 * 36, I_OUT = 12 * 16, I_UP = 16 * 88, I_DN = 44 * 16, I_L = I_IN + I_OUT + I_UP + I_DN;
        const bool heavy = (G == 256) && bx >= 128;
        constexpr int HV_N = 1024;
        const int it0 = (G != 256) ? gw : (heavy ? gw - 1024 : HV_N + (1023 - gw)), itS = (G != 256) ? NGW : 1024, itE = (G != 256) ? 2 * I_L : (heavy ? HV_N : 2 * I_L);
        for (int rp = 0; rp < REP_PT; ++rp)
        for (int it = it0; it < itE; it += itS) {
            const int l = it / I_L; int r = it % I_L;
            unsigned char* wl = ws + WS_W + l * W_LAYER;
            if (r < I_IN) { const int kb = r / 36, sb = r % 36, pn = sb >> 2, wc = sb & 3;
                tr_item64(a.in[7] + (size_t)l * 1024 * INW, INW, 64 * kb, 256 * pn + 64 * wc, (bf16_t*)(wl + WO_IN), 1024, 256 * pn + 32 * wc, 256 * pn + 128 + 32 * wc, pn == 6 || pn == 7, scr, lane); continue; }
            r -= I_IN;
            if (r < I_OUT) { const int kb = r / 16, nb = r % 16;
                tr_item64(a.in[16] + (size_t)l * 1024 * 1024, 1024, 64 * kb, 64 * nb, (bf16_t*)(wl + WO_OUT), 1024, 64 * nb, 64 * nb + 32, false, scr, lane); continue; }
            r -= I_OUT;
            if (r < I_UP) { const int kb = r / 88, sb = r % 88, half = sb / 44, s = sb % 44; const int d0 = 256 * (s >> 1) + 128 * half + 64 * (s & 1);
                tr_item64(a.in[18] + (size_t)l * 1024 * 5632, 5632, 64 * kb, half * DFF + 64 * s, (bf16_t*)(wl + WO_UP), 1024, d0, d0 + 32, false, scr, lane); continue; }
            r -= I_UP;
            { const int kb = r / 16, nb = r % 16;
                tr_item64(a.in[21] + (size_t)l * DFF * 1024, 1024, 64 * kb, 64 * nb, (bf16_t*)(wl + WO_DN), DFF, 64 * nb, 64 * nb + 32, false, scr, lane); }
        }
    }
    for (int rp = 0; rp < REP_PX; ++rp) {
        const int gt = bx * 512 + tid, NT = G * 512;
        f32x2* rope = (f32x2*)(ws + WS_ROPE);
        for (int e = gt; e < 1024; e += NT) { const int pos = e >> 3, f = e & 7; const float inv = exp2f(-(float)f * (13.287712379549449f / 8.f)); const float ang = (float)pos * inv;
            const double rev = (double)ang * 0.15915494309189535; const float fr = (float)(rev - floor(rev)); rope[e] = (f32x2){cospif(2.f * fr), sinpif(2.f * fr)}; }
        f32x2* tw = (f32x2*)(ws + WS_TW);
        for (int e = gt; e < 8192; e += NT) { const float x = (float)e / 4096.f; tw[e] = (f32x2){cospif(x), sinpif(x)}; }
        bf16_t* m1 = (bf16_t*)(ws + WS_M1);
        for (int e = gt; e < 65536; e += NT) { const int rho = e >> 8, kk = e & 255, cp = rho >> 7, k1 = rho & 127, n1 = kk >> 1, c = kk & 1; const float x = (float)((k1 * n1) & 127) / 64.f;
            const float cs = cospif(x) * 0.08838834764831845f, sn = sinpif(x) * 0.08838834764831845f; m1[e] = f2bf(cp == 0 ? (c == 0 ? cs : sn) : (c == 0 ? -sn : cs)); }
        bf16_t* m2 = (bf16_t*)(ws + WS_M2);
        for (int e = gt; e < 131072; e += NT) { const int rho = e >> 9, kk = e & 511, k1lo = rho >> 6, k2 = rho & 63, kl2 = kk >> 7, n2 = (kk >> 1) & 63, c = kk & 1; const float x = (float)((k2 * n2) & 63) / 32.f;
            m2[e] = f2bf(kl2 == k1lo ? (c == 0 ? cospif(x) : sinpif(x)) * 0.125f : 0.f); }
        bf16_t* mc = (bf16_t*)(ws + WS_MC);
        for (int e = gt; e < 131072; e += NT) { const int k = e >> 9, kk = e & 511, n = kk >> 1, c = kk & 1; const float x = (float)((k * n) & 255) / 128.f; mc[e] = f2bf((c == 0 ? cospif(x) : sinpif(x)) * 0.0625f); }
        if (gt < 2) { const float* dl = a.in[13] + gt * 128; float s1 = 0.f, s2 = 0.f; for (int i = 0; i < 32; ++i) { s1 += dl[i] * dl[32 + i]; s2 += dl[64 + i] * dl[96 + i]; }
            const float li = 0.8f - 0.6f * expf(-0.3f * (float)gt); float* lm = (float*)(ws + WS_LAM); lm[2 * gt] = expf(s1) - expf(s2) + li; lm[2 * gt + 1] = 1.f - li; }
    }
}

__device__ __forceinline__ void norm_row(const float* __restrict__ xr, bf16_t* __restrict__ orow, const f32x4 (&gs)[4], const f32x4 (&sh)[4], int lane, float* cp, const float* part, int nparts) {
    f32x4 v[4]; float s = 0.f;
#pragma unroll
    for (int j = 0; j < 4; ++j) { v[j] = *(const f32x4*)(xr + 4 * lane + 256 * j);
        for (int p = 0; p < nparts; ++p) v[j] += *(const f32x4*)(part + (size_t)p * (512 * DM) + 4 * lane + 256 * j);
        if (cp) *(f32x4*)(cp + 4 * lane + 256 * j) = v[j]; s += (v[j][0] * v[j][0] + v[j][1] * v[j][1]) + (v[j][2] * v[j][2] + v[j][3] * v[j][3]); }
    s += SWZ_XOR(s, 1); s += SWZ_XOR(s, 2); s += SWZ_XOR(s, 4); s += SWZ_XOR(s, 8); s += SWZ_XOR(s, 16); s = sum_xor32(s);
    const float rstd = __builtin_amdgcn_rsqf(s * (1.f / 1024.f) + EPS);
#pragma unroll
    for (int j = 0; j < 4; ++j) { const f32x4 y = v[j] * rstd * gs[j] + sh[j]; u32x2 w; w.x = cvtpk(y[0], y[1]); w.y = cvtpk(y[2], y[3]); *(u32x2*)(orow + 4 * lane + 256 * j) = w; }
}
__device__ __forceinline__ void norm_phase(const float* xlat, const float* xctx, const float* g, const float* modl, int sh_off, int sc_off, bf16_t* XN, bool do_ctx, int gw, int NGW, int lane_in, float* ctx_copy, const float* part, int nparts) {
    int lane = lane_in; asm volatile("" : "+v"(lane));
    for (int ch = gw; ch < 2048; ch += NGW) {
        const int v = ch < 1024 ? 0 : 1;
        f32x4 gs[4], sh[4];
#pragma unroll
        for (int j = 0; j < 4; ++j) { const int c = 4 * lane + 256 * j; gs[j] = *(const f32x4*)(g + c) * (*(const f32x4*)(modl + v * 6144 + sc_off + c) + 1.f); sh[j] = *(const f32x4*)(modl + v * 6144 + sh_off + c); }
        for (int i = 0; i < 8; ++i) { const int row = 8 * ch + i; norm_row(xlat + (size_t)row * DM, XN + (size_t)row * DM, gs, sh, lane, nullptr, nullptr, 0); }
    }
    if (do_ctx) {
        for (int rc = NGW - 1 - gw; rc < 2 * CTXL; rc += NGW) {
            f32x4 gs[4], sh[4];
#pragma unroll
            for (int j = 0; j < 4; ++j) { const int c = 4 * lane + 256 * j; gs[j] = *(const f32x4*)(g + c) * (*(const f32x4*)(modl + 2 * 6144 + sc_off + c) + 1.f); sh[j] = *(const f32x4*)(modl + 2 * 6144 + sh_off + c); }
            norm_row(xctx + (size_t)rc * DM, XN + (size_t)(NLAT + rc) * DM, gs, sh, lane, ctx_copy ? ctx_copy + (size_t)rc * DM : nullptr, part + (size_t)rc * DM, nparts);
        }
    }
}
constexpr int LDS_BYTES = 147456;

#ifndef REP_DIFF
#define REP_DIFF 1
#endif
#ifndef REP_NA
#define REP_NA 1
#endif
#ifndef REP_SYNC
#define REP_SYNC 1
#endif
#ifndef REP_PREP
#define REP_PREP 1
#endif
#ifndef REP_UP
#define REP_UP 1
#endif
#ifndef REP_WIN
#define REP_WIN 1
#endif
#ifndef REP_NORM
#define REP_NORM 1
#endif
#define GSYNC() do { for (int _r = 0; _r < REP_SYNC; ++_r) { XcdBarrier xb_ = xbar; { typedef __attribute__((address_space(1))) unsigned gu32_; gu32_* bp_ = (gu32_*)xb_.bar; asm volatile("" : "+s"(bp_)); xb_.bar = (unsigned*)bp_; } xcd_barrier(xb_, wave == 0 && lane_fresh() == 0); } } while (0)
#ifndef SPLITK
#define SPLITK 0
#endif
__global__ void __launch_bounds__(512, 2) hyb_fwd(Args a) {
    extern __shared__ __attribute__((aligned(16))) unsigned char lds_raw[];
    LAS unsigned char* lds = (LAS unsigned char*)lds_raw;
    cg::grid_group grid = cg::this_grid();
    const int wave = __builtin_amdgcn_readfirstlane((int)threadIdx.x >> 6);
#define LANE() lane_fresh()
#define TID() (wave * 64 + LANE())
    const int G = gridDim.x, bx = blockIdx.x;
    unsigned char* ws = a.ws;
    { volatile LAS unsigned* st0 = (volatile LAS unsigned*)(lds + LDS_BYTES - 128); if (wave == 0 && lane_fresh() < 2) st0[lane_fresh()] = 0u; }
    __syncthreads();
    const XcdBarrier xbar = xcd_barrier_post((unsigned*)(ws + WS_BAR), (volatile LAS unsigned*)(lds + LDS_BYTES - 128), wave == 0 && lane_fresh() == 0);
    const int gw = bx * 8 + wave, NGW = G * 8;

    prep_phase(a, lds, TID(), bx, G);
    for (int l = 0; l < 2; ++l) {
        { typedef __attribute__((address_space(1))) unsigned char gu8; gu8* wsg = (gu8*)ws; asm volatile("" : "+s"(wsg)); ws = (unsigned char*)wsg; }
        const float* modl = (const float*)(ws + WS_MOD) + l * 3 * 6144;
        bf16_t* XN = (bf16_t*)(ws + WS_XN) + DM;
        bf16_t* Pb = (bf16_t*)(ws + WS_P); bf16_t* Zt = (bf16_t*)(ws + WS_ZT); bf16_t* ZtC = (bf16_t*)(ws + WS_ZTC); bf16_t* A2t = (bf16_t*)(ws + WS_A2T);
        bf16_t* Yb = (bf16_t*)(ws + WS_Y); bf16_t* A2 = (bf16_t*)(ws + WS_A2); float* XC = (float*)(ws + WS_XC);
        unsigned char* wl = ws + WS_W + l * W_LAYER;
        const float* xin = l == 0 ? a.in[0] : a.out; const float* cin = l == 0 ? a.in[2] : XC;
        const bool ctxl = (l == 0);
        if (l == 0) {
            if (wave == 0 && lane_fresh() == 0) { unsigned sp = 0; while (xb_ld((unsigned*)(ws + WS_BAR) + 3648) < 192u && ++sp < (1u << 22)) __builtin_amdgcn_s_sleep(2);
                __builtin_amdgcn_fence(__ATOMIC_ACQUIRE, "agent"); asm volatile("s_waitcnt vmcnt(0)" ::: "memory"); }
            __syncthreads();
        }
        norm_phase(xin, cin, a.in[6] + l * DM, modl, 0, 1024, XN, true, gw, NGW, LANE(), XC, (const float*)(ws + WS_PART), (SPLITK && !ctxl) ? 11 : 0);
        if (l == 0) grid.sync();
        else GSYNC();
        {
            pg8::Gemm g{XN, (const bf16_t*)(wl + WO_IN), 1024, 0, (size_t)128 * 1024 * 2, (size_t)256 * 1024 * 2, 1024, 1024};
            pg8::TileOrder S; S.init(MT / 256, 9, G, bx);
            EpiWin E{Pb, Zt, ZtC, a.in[8] + l * 64, a.in[9] + l * 64, a.in[11] + l * 32, a.in[12] + l * 32, (const f32x2*)(ws + WS_ROPE)};
#ifndef NO_WIN
            for (int rep = 0; rep < REP_WIN; ++rep) {
                pg8::gemm_phase<EpiWin, pg8::TileOrder>(lds, g, S, E, wave);
                pg8::Gemm gz{XN, (const bf16_t*)(wl + WO_IN) + (size_t)2304 * 1024, 1024, 2, (size_t)256 * 1024 * 2, (size_t)0, 1024, 1024};
                pg8::TileOrder Sz; Sz.init(MT / 256, 2, G, (bx + G - 82) % G);
                EpiZ Ez{Zt, ZtC};
                pg8::gemm_phase<EpiZ, pg8::TileOrder>(lds, gz, Sz, Ez, wave);
            }
#endif
        }
        GSYNC();
        {
            unsigned* f1cnt = (unsigned*)(ws + WS_BAR) + 3520 + 64 * l;
#ifndef NO_NA
            for (int rep = 0; rep < REP_NA; ++rep)
            for (int u = bx; u < (ctxl ? 264 : 256); u += G) {
                if (u < 256) { const int xcd = u & 7, slot = u >> 3, b = slot >> 4, r = 16 * xcd + (slot & 15);
                    na_unit(lds, Pb, Yb, a.in[10] + l * 8 * 15 * 31, b * SEQ + 64 * r, b, r, wave, LANE()); }
                else { const int b = (u - 256) >> 2, qb = u & 3; na_unit(lds, Pb, Yb, a.in[10], NLAT + b * CTXL + 64 * qb, b, -1, wave, LANE()); }
            }
#endif
            __syncthreads();
            {
                pg8::Gemm g{(const bf16_t*)(ws + WS_M1), Zt, 256, 0, (size_t)128 * 256 * 2, (size_t)256 * 256 * 2, 256, 256};
                const int c1 = (bx + G / 2) % G;
                pg8::TileOrder S; S.init(1, 128, G, c1);
                EpiF1 E{A2t, (const f32x2*)(ws + WS_TW)};
#ifndef NO_F1
                pg8::gemm_phase<EpiF1, pg8::TileOrder>(lds, g, S, E, wave);
#endif
                if (c1 < 128) {
                    int n1 = 0; for (int L = c1; L < 128; L += G) ++n1;
                    if (wave == 0 && lane_fresh() == 0) { __builtin_amdgcn_fence(__ATOMIC_RELEASE, "agent"); asm volatile("s_waitcnt vmcnt(0)" ::: "memory"); xb_add(f1cnt, (unsigned)n1); }
                }
            }
            __syncthreads();
#ifndef NO_DIFF
            const float lam = ((const float*)(ws + WS_LAM))[2 * l], oms = ((const float*)(ws + WS_LAM))[2 * l + 1];
            for (int rep = 0; rep < REP_DIFF; ++rep)
            for (int u = bx; u < (ctxl ? 264 : 256); u += G) {
                int qrow0, b, h, t0;
                if (u < 256) { const int bh = u & 7, qb = u >> 3; b = bh >> 2; h = bh & 3; qrow0 = b * SEQ + 256 * qb; t0 = 0; }
                else { b = (u - 256) >> 2; h = u & 3; qrow0 = NLAT + b * CTXL; t0 = 128; }
                diff_unit(lds, Pb, Yb, a.in[14] + l * 64, qrow0, b, h, t0, 132, lam, oms, TID());
            }
#endif
            __syncthreads();
#ifndef NO_F2
            for (int pass = 0; pass < (ctxl ? 2 : 1); ++pass) {
                const int c2 = pass ? (bx + G - 72) % G : (bx + G - 8) % G;
                if (pass == 0 && c2 < 64) {
                    if (wave == 0 && lane_fresh() == 0) { unsigned sp = 0; while (xb_ld(f1cnt) < 128u && ++sp < (1u << 22)) __builtin_amdgcn_s_sleep(2);
                        __builtin_amdgcn_fence(__ATOMIC_ACQUIRE, "agent"); asm volatile("s_waitcnt vmcnt(0)" ::: "memory"); }
                    __syncthreads();
                }
                pg8::Gemm g{(const bf16_t*)(ws + (pass ? WS_MC : WS_M2)), pass ? ZtC : A2t, 512, 0, (size_t)128 * 512 * 2, (size_t)256 * 512 * 2, 512, 512};
                pg8::TileOrder S; S.init(1, pass ? 2 : 64, G, c2);
                EpiF2 E{Yb, pass};
                pg8::gemm_phase<EpiF2, pg8::TileOrder>(lds, g, S, E, wave);
            }
#endif
        }
        GSYNC();
        {
            for (int pass = 0; pass < ((ctxl && SPLITK) ? 2 : 1); ++pass) {
                pg8::Gemm g{Yb, (const bf16_t*)(wl + WO_OUT), pass ? 256 : 1024, 0, (size_t)128 * 1024 * 2, (size_t)256 * 1024 * 2, 1024, 1024};
                pg8::TileOrder S; S.init((ctxl && !SPLITK) ? 66 : 64, 4, G, bx, pass ? 4 : 0);
                EpiRes E{xin, a.out, XC, XC, modl + 2048, pass ? (float*)(ws + WS_PART) : nullptr};
                pg8::gemm_phase<EpiRes, pg8::TileOrder>(lds, g, S, E, wave);
            }
        }
        GSYNC();
#ifndef NO_NORM
        for (int rep = 0; rep < REP_NORM; ++rep) norm_phase(a.out, XC, a.in[17] + l * DM, modl, 3072, 4096, XN, ctxl, gw, NGW, LANE(), XC, (const float*)(ws + WS_PART), SPLITK ? 4 : 0);
#endif
        GSYNC();
        {
            const int Mrows = ctxl ? MT : NLAT;
            pg8::Gemm g{XN - DM, (const bf16_t*)(wl + WO_UP), 1024, 1, (size_t)4 * 1024 * 2, (size_t)252 * 1024 * 2, 1024, 1024};
            pg8::TileOrder S; S.init((Mrows + 251) / 252, 22, G, bx);
            EpiUp E{A2, a.in[19] + (size_t)l * 3 * 5632, a.in[20] + (size_t)l * 5632, Mrows};
#ifndef NO_UP
            for (int rep = 0; rep < REP_UP; ++rep) pg8::gemm_phase<EpiUp, pg8::TileOrder>(lds, g, S, E, wave);
#endif
        }
        GSYNC();
        {
            for (int pass = 0; pass < ((ctxl && SPLITK) ? 2 : 1); ++pass) {
                pg8::Gemm g{A2, (const bf16_t*)(wl + WO_DN), pass ? 256 : DFF, 0, (size_t)128 * DFF * 2, (size_t)256 * DFF * 2, DFF, DFF};
                pg8::TileOrder S; S.init((ctxl && !SPLITK) ? 66 : 64, 4, G, pass ? (bx + 128) % G : bx, pass ? 11 : 0);
                EpiRes E{a.out, a.out, XC, XC, modl + 5120, pass ? (float*)(ws + WS_PART) : nullptr};
                pg8::gemm_phase<EpiRes, pg8::TileOrder>(lds, g, S, E, wave);
            }
        }
        if (l == 0) GSYNC();
    }
}

extern "C" void kernel_launch(void* const* d_in, const int* in_sizes, int n_in, void* d_out, int out_size, void* d_ws, size_t ws_size, hipStream_t stream) {
    static int grid = 0;
    if (grid == 0) {
        if (n_in != 22 || out_size != NLAT * DM || ws_size < WS_END) { fprintf(stderr, "kernel_launch: unexpected shapes (n_in %d out %d ws %zu)\n", n_in, out_size, ws_size); grid = -1; return; }
        int dev = 0, cus = 0, per = 0;
        (void)hipGetDevice(&dev); (void)hipDeviceGetAttribute(&cus, hipDeviceAttributeMultiprocessorCount, dev);
        (void)hipFuncSetAttribute((const void*)hyb_fwd, hipFuncAttributeMaxDynamicSharedMemorySize, LDS_BYTES);
        (void)hipOccupancyMaxActiveBlocksPerMultiprocessor(&per, (const void*)hyb_fwd, 512, LDS_BYTES);
        (void)hipGetLastError();
        if (per < 1) fprintf(stderr, "kernel_launch: occupancy query says %d blocks/CU\n", per);
        grid = cus;
    }
    if (grid < 0) return;
    (void)hipMemsetAsync((unsigned char*)d_ws + WS_BAR, 0, 16384, stream);
    Args a{};
    for (int i = 0; i < 22; ++i) a.in[i] = (const float*)d_in[i];
    a.out = (float*)d_out; a.ws = (unsigned char*)d_ws;
    void* args[] = {&a};
    hipError_t e = hipLaunchCooperativeKernel((const void*)hyb_fwd, dim3(grid), dim3(512), args, LDS_BYTES, stream);
    if (e != hipSuccess) fprintf(stderr, "kernel_launch: cooperative launch failed: %s (grid %d)\n", hipGetErrorString(e), grid);
}
```

```cpp
#include <hip/hip_runtime.h>
#include <hip/hip_cooperative_groups.h>
#include <cstdio>
#include <cstdint>
namespace cg = cooperative_groups;

#define LAS __attribute__((address_space(3)))
typedef unsigned short bf16_t;
typedef short bf16x8 __attribute__((ext_vector_type(8)));
typedef short s16x4 __attribute__((ext_vector_type(4)));
typedef float f32x4 __attribute__((ext_vector_type(4)));
typedef float f32x2 __attribute__((ext_vector_type(2)));
typedef float f32x16 __attribute__((ext_vector_type(16)));
typedef unsigned u32x4 __attribute__((ext_vector_type(4)));
typedef unsigned u32x2 __attribute__((ext_vector_type(2)));
typedef __bf16 bf16x2_t __attribute__((ext_vector_type(2)));

constexpr int SEQ = 8192, DM = 1024, CTXL = 256, NLAT = 2 * SEQ, MT = NLAT + 2 * CTXL;
constexpr int PP = 2304;
constexpr int NAQ0 = 0, NAK0 = 512, NAV0 = 1024, DQ0 = 1536, DK0 = 1792, DV0 = 2048, FN0 = 2304, INW = 2560;
constexpr int NIN = 2816;
constexpr int DFF = 2816;
constexpr float EPS = 1e-6f, LOG2E = 1.4426950408889634f;

__device__ __forceinline__ unsigned cvtpk(float lo, float hi) { f32x2 v = {lo, hi}; bf16x2_t b = __builtin_convertvector(v, bf16x2_t); return __builtin_bit_cast(unsigned, b); }
__device__ __forceinline__ int lane_fresh() { int l; asm volatile("v_mbcnt_lo_u32_b32 %0, -1, 0\n\tv_mbcnt_hi_u32_b32 %0, -1, %0" : "=v"(l)); return l; }
__device__ __forceinline__ int lane_fresh();
__device__ __forceinline__ float bperm_xor(float v, int m) { int l; asm volatile("v_mbcnt_lo_u32_b32 %0, -1, 0\n\tv_mbcnt_hi_u32_b32 %0, -1, %0" : "=v"(l)); return __builtin_bit_cast(float, __builtin_amdgcn_ds_bpermute((l ^ m) << 2, __builtin_bit_cast(int, v))); }
#define SWZ_XOR(v, m) bperm_xor((v), (m))
__device__ __forceinline__ float sum_xor32(float v) { return v + bperm_xor(v, 32); }
__device__ __forceinline__ bf16_t f2bf(float f) { return (bf16_t)(cvtpk(f, 0.f) & 0xffffu); }

namespace pg8 {
constexpr int BM = 256, BK = 64, HALF = 128, HTB = HALF * BK * 2, STAGE_BYTES = 8 * HTB, NXCD = 8, WGM = 8;
__host__ __device__ __forceinline__ int lds_byte(int r, int c) { const int st = (r >> 4) * 2 + (c >> 5), rr = r & 15, cc = c & 31, ob = rr * 64 + cc * 2; return st * 1024 + (ob ^ (((ob >> 9) & 1) << 5)); }
__host__ __device__ __forceinline__ void stage_rc(int b, int& R, int& C) { const int st = b / 1024, sb = b % 1024, swz = sb ^ (((sb >> 9) & 1) << 5); R = (st >> 1) * 16 + swz / 64; C = (st & 1) * 32 + (swz % 64) / 2; }
__host__ __device__ __forceinline__ int perm32(int rho) { const int n = rho >> 4, i = rho & 15; return 8 * (i >> 2) + 4 * n + (i & 3); }

struct Unit { int pm, pn, kc; };
struct Gemm { const bf16_t* A; const bf16_t* Bt; int K; int amode; size_t a_half, a_tile; int lda, ldb; };

struct TileOrder {
    int nM, nN, nwg, G, c, nk;
    __device__ void init(int nM_, int nN_, int G_, int c_, int nk_ = 0) { nM = nM_; nN = nN_; nwg = nM * nN; G = G_; c = c_; nk = nk_; }
    __device__ bool next(int i, Unit& u) const {
        if (nk > 0) { const int L2 = i * G + c; if (L2 >= 8 * nk) return false; u.pm = 64 + (L2 & 1); u.pn = (L2 >> 1) & 3; u.kc = L2 >> 3; return true; }
        const long L = (long)i * G + c; if (L >= nwg) return false;
        int wgid = (int)L; { const int q = nwg / NXCD, r = nwg % NXCD, xcd = wgid % NXCD, off = wgid / NXCD; wgid = (xcd < r ? xcd * (q + 1) : r * (q + 1) + (xcd - r) * q) + off; }
        const int nig = WGM * nN, gid = wgid / nig, fm = gid * WGM, gsz = (nM - fm) < WGM ? (nM - fm) : WGM;
        u.pm = fm + ((wgid % nig) % gsz); u.pn = (wgid % nig) / gsz; u.kc = 0; return true;
    }
};

template <class Epi, class Sched, bool ALIGN_EPI = true>
__device__ __forceinline__ void gemm_phase(LAS unsigned char* lds, const Gemm g, const Sched& S, const Epi& E, int wid) {
    const int lane = lane_fresh(), tid = wid * 64 + lane, wr = wid >> 2, wc = wid & 3, fr = lane & 15, fq = lane >> 4;
    const int K = g.K, nt = K / BK;
    unsigned voffA[2], voffB[2];
#pragma unroll
    for (int i = 0; i < 2; ++i) { int R, C; stage_rc(tid * 16 + i * 8192, R, C); const int Rb = Epi::PERM ? ((R & ~31) + perm32(R & 31)) : R;
        const int Ra = g.amode == 1 ? (126 * (R >> 6) + 8 * (R & 15) + ((R >> 4) & 3)) : (g.amode == 2 ? (64 * ((R >> 4) & 3) + 16 * (R >> 6) + (R & 15)) : R);
        voffA[i] = (unsigned)(Ra * g.lda + C) * 2u; voffB[i] = (unsigned)(Rb * g.ldb + C) * 2u; }
    const size_t kstep = (size_t)(BK * 2);
    const size_t hstepB = (size_t)HALF * g.ldb * 2, tstepB = 2 * hstepB, kchunk = (size_t)K * 2;
    const size_t hstepA = g.a_half, tstepA = g.a_tile;
    const unsigned ldsw = (unsigned)wid * 1024u;
    const int aoff = lds_byte(wr * 64 + fr, fq * 8), boff = lds_byte(wc * 32 + fr, fq * 8);
#define PG8_SA(b, h) (((b) * 2 + (h)) * HTB)
#define PG8_SB(b, h) ((4 + (b) * 2 + (h)) * HTB)
#define PG8_STAGE(bufoff, gbase, voff) do { _Pragma("unroll") for (int _i = 0; _i < 2; ++_i) \
        __builtin_amdgcn_global_load_lds((const unsigned*)((const char*)(gbase) + (voff)[_i]), (LAS unsigned*)(lds + (bufoff) + ldsw + _i * 8192), 16, 0, 0); } while (0)
#define PG8_LDA(dst, b, h) do { _Pragma("unroll") for (int m = 0; m < 4; ++m) _Pragma("unroll") for (int k = 0; k < 2; ++k) dst[m][k] = *(const LAS bf16x8*)(lds + PG8_SA(b, h) + aoff + m * 2048 + k * 1024); } while (0)
#define PG8_LDB(dst, b, h) do { _Pragma("unroll") for (int n = 0; n < 2; ++n) _Pragma("unroll") for (int k = 0; k < 2; ++k) dst[n][k] = *(const LAS bf16x8*)(lds + PG8_SB(b, h) + boff + n * 2048 + k * 1024); } while (0)
#define PG8_MMA(ai, bj, At, Bt) do { __builtin_amdgcn_s_setprio(1); _Pragma("unroll") for (int m = 0; m < 4; ++m) _Pragma("unroll") for (int n = 0; n < 2; ++n) _Pragma("unroll") for (int k = 0; k < 2; ++k) \
        acc[ai][bj][m][n] = __builtin_amdgcn_mfma_f32_16x16x32_bf16(Bt[n][k], At[m][k], acc[ai][bj][m][n], 0, 0, 0); __builtin_amdgcn_s_setprio(0); } while (0)
#define PG8_WAIT_V(n) asm volatile("s_waitcnt vmcnt(" #n ")" ::: "memory")
#define PG8_WAIT_L(n) asm volatile("s_waitcnt lgkmcnt(" #n ")" ::: "memory")
#define PG8_BAR __builtin_amdgcn_s_barrier()
#define PG8_SCHED __builtin_amdgcn_sched_barrier(0)
    Unit cur, nxt; int ui = 0;
    if (!S.next(0, cur)) return;
    f32x4 acc[2][2][4][2];
#pragma unroll
    for (int a = 0; a < 2; ++a)
#pragma unroll
        for (int b = 0; b < 2; ++b)
#pragma unroll
            for (int m = 0; m < 4; ++m)
#pragma unroll
                for (int n = 0; n < 2; ++n) acc[a][b][m][n] = (f32x4){0.f, 0.f, 0.f, 0.f};
    bf16x8 At[4][2], B0[2][2], B1[2][2];
#define PG8_ABASE(pm_) (g.amode == 2 ? (size_t)(((pm_) >> 1) * 512 + ((pm_) & 1) * 32) * g.lda * 2 : (size_t)(pm_) * tstepA)
    const char* cA = (const char*)g.A + PG8_ABASE(cur.pm) + (size_t)cur.kc * kchunk; const char* cB = (const char*)g.Bt + (size_t)cur.pn * tstepB + (size_t)cur.kc * kchunk;
    {
        PG8_STAGE(PG8_SB(0, 0), cB, voffB); PG8_STAGE(PG8_SB(0, 1), cB + hstepB, voffB); PG8_STAGE(PG8_SA(0, 0), cA, voffA); PG8_STAGE(PG8_SA(0, 1), cA + hstepA, voffA);
        if (wr == 1) PG8_BAR;
        PG8_WAIT_V(2); PG8_BAR;
        PG8_STAGE(PG8_SB(1, 0), cB + kstep, voffB); PG8_STAGE(PG8_SA(1, 0), cA + kstep, voffA); PG8_STAGE(PG8_SB(1, 1), cB + hstepB + kstep, voffB);
        PG8_WAIT_V(6); PG8_BAR;
    }
    for (;;) {
        const bool has_next = S.next(ui + 1, nxt);
        const char* nA = has_next ? (const char*)g.A + PG8_ABASE(nxt.pm) + (size_t)nxt.kc * kchunk : cA; const char* nB = has_next ? (const char*)g.Bt + (size_t)nxt.pn * tstepB + (size_t)nxt.kc * kchunk : cB;
        for (int t = 0; t < nt; t += 2) {
            const bool last = (t == nt - 2);
            const char* a1 = cA + (size_t)(t + 1) * kstep;
            const char* a2 = last ? nA : cA + (size_t)(t + 2) * kstep; const char* b2 = last ? nB : cB + (size_t)(t + 2) * kstep;
            const char* a3 = a2 + kstep; const char* b3 = b2 + kstep;
            PG8_LDB(B0, 0, 0); PG8_LDB(B1, 0, 1); PG8_SCHED; PG8_LDA(At, 0, 0); PG8_STAGE(PG8_SA(1, 1), a1 + hstepA, voffA);
            PG8_WAIT_V(8); PG8_WAIT_L(0); PG8_BAR; PG8_MMA(0, 0, At, B0); PG8_MMA(0, 1, At, B1); PG8_BAR; PG8_SCHED;
            PG8_LDA(At, 0, 1); PG8_STAGE(PG8_SB(0, 0), b2, voffB); PG8_STAGE(PG8_SB(0, 1), b2 + hstepB, voffB); PG8_STAGE(PG8_SA(0, 0), a2, voffA);
            PG8_WAIT_V(8); PG8_WAIT_L(0); PG8_BAR; PG8_MMA(1, 0, At, B0); PG8_MMA(1, 1, At, B1); PG8_BAR; PG8_SCHED;
            PG8_LDB(B0, 1, 0); PG8_LDB(B1, 1, 1); PG8_SCHED; PG8_LDA(At, 1, 0); PG8_STAGE(PG8_SA(0, 1), a2 + hstepA, voffA);
            PG8_WAIT_V(8); PG8_WAIT_L(0); PG8_BAR; PG8_MMA(0, 0, At, B0); PG8_MMA(0, 1, At, B1); PG8_BAR; PG8_SCHED;
            PG8_LDA(At, 1, 1); PG8_STAGE(PG8_SB(1, 0), b3, voffB); PG8_STAGE(PG8_SB(1, 1), b3 + hstepB, voffB); PG8_STAGE(PG8_SA(1, 0), a3, voffA);
            PG8_WAIT_V(8); PG8_WAIT_L(0); PG8_BAR; PG8_MMA(1, 0, At, B0); PG8_MMA(1, 1, At, B1); PG8_BAR; PG8_SCHED;
        }
        if constexpr (ALIGN_EPI) { if (wr == 0) PG8_BAR; }
        { const int ln = lane_fresh(); E(acc, cur, wr, wc, ln & 15, ln >> 4); }
        if (!has_next) break;
#pragma unroll
        for (int a = 0; a < 2; ++a)
#pragma unroll
            for (int b = 0; b < 2; ++b)
#pragma unroll
                for (int m = 0; m < 4; ++m)
#pragma unroll
                    for (int n = 0; n < 2; ++n) acc[a][b][m][n] = (f32x4){0.f, 0.f, 0.f, 0.f};
        cur = nxt; cA = nA; cB = nB; ++ui;
        if constexpr (ALIGN_EPI) { if (wr == 1) PG8_BAR; }
    }
    PG8_WAIT_V(0);
    if constexpr (!ALIGN_EPI) { if (wr == 0) PG8_BAR; }
    PG8_BAR;
#undef PG8_ABASE
#undef PG8_SA
#undef PG8_SB
#undef PG8_STAGE
#undef PG8_LDA
#undef PG8_LDB
#undef PG8_MMA
#undef PG8_WAIT_V
#undef PG8_WAIT_L
#undef PG8_BAR
#undef PG8_SCHED
}
}
#define RLX_AGENT __ATOMIC_RELAXED, __HIP_MEMORY_SCOPE_AGENT
#define XB_TMO      128
#define XB_XCNT(j)  (256  + 64 * (j))
#define XB_XSUB(j)  (1280 + 64 * (j))
#define XB_XGEN(j)  (2304 + 64 * (j))
#define XB_TOP      3328
#define XB_TOPGEN   3392
#define XCD_BAR_WORDS 3456
#define XB_SPIN_CAP (1u << 18)

__device__ __forceinline__ unsigned xb_ld(unsigned* p)              { return __hip_atomic_load(p, __ATOMIC_RELAXED, __HIP_MEMORY_SCOPE_AGENT); }
__device__ __forceinline__ unsigned xb_add(unsigned* p, unsigned v) { return __hip_atomic_fetch_add(p, v, __ATOMIC_RELAXED, __HIP_MEMORY_SCOPE_AGENT); }
__device__ __forceinline__ unsigned xb_xcc_id() { return (unsigned)__builtin_amdgcn_s_getreg((3 << 11) | 20) & 0xFu; }
#define XB_SPIN(cond, bar) do { unsigned _sp = 0; while (cond) { __builtin_amdgcn_s_sleep(1); \
    if ((++_sp & 255u) == 0u) { if (xb_ld(&(bar)[XB_TMO])) break; if (_sp > XB_SPIN_CAP) { atomicAdd(&(bar)[XB_TMO], 1u); break; } } } } while (0)

struct XcdBarrier {
    unsigned* bar; unsigned x;
    volatile LAS unsigned* st;
};

__device__ __forceinline__ XcdBarrier xcd_barrier_post(unsigned* bar, volatile LAS unsigned* st, bool t0) {
    XcdBarrier b; b.bar = bar; b.x = xb_xcc_id(); b.st = st;
    if (t0) (void)xb_add(&bar[XB_XCNT(b.x)], 1u);
    return b;
}
__device__ __forceinline__ void xcd_barrier_complete(unsigned* bar, unsigned x, unsigned& nloc, unsigned& nx) {
    const unsigned G = gridDim.x * gridDim.y * gridDim.z;
    unsigned sum, cnt, mine, sp = 0u;
    for (;;) {
        sum = 0u; cnt = 0u; mine = 0u;
#pragma unroll
        for (unsigned j = 0; j < 16; ++j) { const unsigned c = xb_ld(&bar[XB_XCNT(j)]); sum += c; cnt += (c > 0u) ? 1u : 0u; mine = (j == x) ? c : mine; }
        if (sum == G) break;
        __builtin_amdgcn_s_sleep(1);
        if ((++sp & 255u) == 0u) { if (xb_ld(&bar[XB_TMO])) break; if (sp > XB_SPIN_CAP) { atomicAdd(&bar[XB_TMO], 1u); break; } }
    }
    nloc = mine > 0u ? mine : 1u; nx = cnt > 0u ? cnt : 1u;
}

__device__ __forceinline__ void xcd_barrier(const XcdBarrier& b, bool t0) {
    asm volatile("s_waitcnt vmcnt(0)" ::: "memory");
    __syncthreads();
    if (t0) {
        unsigned* bar = b.bar;
        __builtin_amdgcn_s_waitcnt(0);
        unsigned nloc = b.st[0], nx = b.st[1];
        if (nloc == 0u) { xcd_barrier_complete(bar, b.x, nloc, nx); b.st[0] = nloc; b.st[1] = nx; }
        const unsigned old = xb_add(&bar[XB_XSUB(b.x)], 1u);
        const unsigned gen = old / nloc;
        if (old + 1u == (gen + 1u) * nloc) {
            __builtin_amdgcn_fence(__ATOMIC_RELEASE, "agent");
            asm volatile("s_waitcnt vmcnt(0)" ::: "memory");
            const unsigned og = xb_add(&bar[XB_TOP], 1u);
            const unsigned tg = og / nx;
            if (og + 1u == (tg + 1u) * nx) xb_add(&bar[XB_TOPGEN], 1u);
            else XB_SPIN(xb_ld(&bar[XB_TOPGEN]) == tg, bar);
            __builtin_amdgcn_fence(__ATOMIC_ACQUIRE, "agent");
            xb_add(&bar[XB_XGEN(b.x)], 1u);
            asm volatile("s_waitcnt vmcnt(0)" ::: "memory");
        } else {
            XB_SPIN(xb_ld(&bar[XB_XGEN(b.x)]) == gen, bar);
            __builtin_amdgcn_fence(__ATOMIC_ACQUIRE, "agent");
            asm volatile("s_waitcnt vmcnt(0)" ::: "memory");
        }
    }
    __syncthreads();
}

using pg8::Unit;
__device__ __forceinline__ int dimperm(int i) { const int fq = i >> 3, n = (i >> 2) & 1, j = i & 3, pi = 4 * fq + j; return (pi < 8 ? pi : 8 + pi) + 8 * n; }

struct EpiWin {
    static constexpr bool PERM = true;
    bf16_t* P; bf16_t* Zt; bf16_t* ZtC; const float* nqg; const float* nkg; const float* dqg; const float* dkg; const f32x2* rope;
    __device__ __forceinline__ void operator()(const f32x4 (&acc)[2][2][4][2], const Unit& u, int wr, int wc, int fr_, int fq_) const {
        int fr = fr_, fq = fq_; asm volatile("" : "+v"(fr), "+v"(fq));
        const int pn = u.pn, row0 = u.pm * 256 + wr * 64 + fr;
        if (pn >= 9) {
            const int gma = 128 * (pn - 9) + 16 * wc + 4 * fq;
#pragma unroll
            for (int ai = 0; ai < 2; ++ai)
#pragma unroll
                for (int m = 0; m < 4; ++m) {
                    const int row = row0 + 128 * ai + 16 * m;
#pragma unroll
                    for (int bj = 0; bj < 2; ++bj)
#pragma unroll
                        for (int n = 0; n < 2; ++n) {
                            const f32x4 v = acc[ai][bj][m][n]; const unsigned w0 = cvtpk(v[0], v[1]), w1 = cvtpk(v[2], v[3]);
                            const int gm = gma + 64 * bj + 2 * n;
                            if (row < NLAT) {
                                const int b = row >> 13, nn = row & 8191, n1 = nn >> 6, n2 = nn & 63;
                                const size_t r0 = ((((size_t)(b * 16 + (gm >> 4)) * 4 + (n2 >> 4)) * 16 + (gm & 15)) * 16 + (n2 & 15));
                                *(unsigned*)(Zt + r0 * 256 + 2 * n1) = w0;
                                *(unsigned*)(Zt + (r0 + 16) * 256 + 2 * n1) = w1;
                            } else {
                                const int rc = row - NLAT, b = rc >> 8, nn = rc & 255;
                                *(unsigned*)(ZtC + ((size_t)(b * 256 + gm)) * 512 + 2 * nn) = w0;
                                *(unsigned*)(ZtC + ((size_t)(b * 256 + gm + 1)) * 512 + 2 * nn) = w1;
                            }
                        }
                }
            return;
        }
        const int colb = 256 * pn + 64 * wc + 8 * fq;
        if (pn == 4 || pn == 5 || pn == 8) {
#pragma unroll
            for (int ai = 0; ai < 2; ++ai)
#pragma unroll
                for (int m = 0; m < 4; ++m) { bf16_t* rowp = P + (size_t)(row0 + 128 * ai + 16 * m) * PP + colb;
#pragma unroll
                    for (int bj = 0; bj < 2; ++bj) { const f32x4 v0 = acc[ai][bj][m][0], v1 = acc[ai][bj][m][1]; u32x4 w; w.x = cvtpk(v0[0], v0[1]); w.y = cvtpk(v0[2], v0[3]); w.z = cvtpk(v1[0], v1[1]); w.w = cvtpk(v1[2], v1[3]);
                        *(u32x4*)(rowp + 32 * bj) = w; } }
            return;
        }
        if (pn < 4) {
            const bool isq = pn < 2; const float* gp = (isq ? nqg : nkg) + 8 * fq;
            const float osc = isq ? 0.125f * LOG2E : 1.0f;
            f32x4 gv[2][2];
#pragma unroll
            for (int bj = 0; bj < 2; ++bj)
#pragma unroll
                for (int n = 0; n < 2; ++n) gv[bj][n] = *(const f32x4*)(gp + 32 * bj + 4 * n) * osc;
#pragma unroll
            for (int ai = 0; ai < 2; ++ai)
#pragma unroll
                for (int m = 0; m < 4; ++m) {
                    float ss = 0.f;
#pragma unroll
                    for (int bj = 0; bj < 2; ++bj)
#pragma unroll
                        for (int n = 0; n < 2; ++n) { const f32x4 v = acc[ai][bj][m][n]; ss += (v[0] * v[0] + v[1] * v[1]) + (v[2] * v[2] + v[3] * v[3]); }
                    ss += SWZ_XOR(ss, 16); ss = sum_xor32(ss);
                    const float rstd = __builtin_amdgcn_rsqf(ss * (1.f / 64.f) + EPS);
                    bf16_t* rowp = P + (size_t)(row0 + 128 * ai + 16 * m) * PP + colb;
#pragma unroll
                    for (int bj = 0; bj < 2; ++bj) { const f32x4 v0 = acc[ai][bj][m][0] * rstd * gv[bj][0], v1 = acc[ai][bj][m][1] * rstd * gv[bj][1];
                        u32x4 w; w.x = cvtpk(v0[0], v0[1]); w.y = cvtpk(v0[2], v0[3]); w.z = cvtpk(v1[0], v1[1]); w.w = cvtpk(v1[2], v1[3]);
                        *(u32x4*)(rowp + 32 * bj) = w; }
                }
            return;
        }
        {
            const bool isq = pn == 6; const float* gp = isq ? dqg : dkg;
            const float osc = isq ? 0.17677669529663687f * LOG2E : 1.0f;
            const bool lat = u.pm < 64;
            f32x4 gv[2];
#pragma unroll
            for (int n = 0; n < 2; ++n)
#pragma unroll
                for (int j = 0; j < 4; ++j) gv[n][j] = gp[dimperm(8 * fq + 4 * n + j)];
#pragma unroll
            for (int ai = 0; ai < 2; ++ai)
#pragma unroll
                for (int m = 0; m < 4; ++m) {
                    const int row = row0 + 128 * ai + 16 * m;
                    f32x2 cs[4];
                    if (lat) { const int gr = (row >> 6) & 127, gc = row & 63; const int pos = (fq < 2) ? gr : gc;
#pragma unroll
                        for (int j = 0; j < 4; ++j) cs[j] = rope[pos * 8 + ((4 * fq + j) & 7)]; }
                    else {
#pragma unroll
                        for (int j = 0; j < 4; ++j) cs[j] = (f32x2){1.f, 0.f}; }
                    bf16_t* rowp = P + (size_t)row * PP + colb;
#pragma unroll
                    for (int bj = 0; bj < 2; ++bj) {
                        const f32x4 a0 = acc[ai][bj][m][0], a1 = acc[ai][bj][m][1];
                        float ss = (a0[0] * a0[0] + a0[1] * a0[1]) + (a0[2] * a0[2] + a0[3] * a0[3]) + (a1[0] * a1[0] + a1[1] * a1[1]) + (a1[2] * a1[2] + a1[3] * a1[3]);
                        ss += SWZ_XOR(ss, 16); ss = sum_xor32(ss);
                        const float rstd = __builtin_amdgcn_rsqf(ss * (1.f / 32.f) + EPS);
                        const f32x4 x1 = a0 * rstd * gv[0], x2 = a1 * rstd * gv[1];
                        f32x4 y1, y2;
#pragma unroll
                        for (int j = 0; j < 4; ++j) { y1[j] = (x1[j] * cs[j].x - x2[j] * cs[j].y) * osc; y2[j] = (x1[j] * cs[j].y + x2[j] * cs[j].x) * osc; }
                        u32x4 w; w.x = cvtpk(y1[0], y1[1]); w.y = cvtpk(y1[2], y1[3]); w.z = cvtpk(y2[0], y2[1]); w.w = cvtpk(y2[2], y2[3]);
                        *(u32x4*)(rowp + 32 * bj) = w;
                    }
                }
        }
    }
};

struct EpiZ {
    static constexpr bool PERM = true;
    bf16_t* Zt; bf16_t* ZtC;
    __device__ __forceinline__ void operator()(const f32x4 (&acc)[2][2][4][2], const Unit& u, int wr, int wc, int fr_, int fq_) const {
        int fr = fr_, fq = fq_; asm volatile("" : "+v"(fr), "+v"(fq));
        const int gma = 128 * u.pn + 16 * wc + 4 * fq;
        if (u.pm < 64) {
            const int b = u.pm >> 5, tp = u.pm & 31, n1b = 8 * (tp >> 1), n2 = 32 * (tp & 1) + 16 * wr + fr;
#pragma unroll
            for (int bj = 0; bj < 2; ++bj)
#pragma unroll
                for (int n = 0; n < 2; ++n)
#pragma unroll
                    for (int p = 0; p < 2; ++p) {
                        const int gm = gma + 64 * bj + 2 * n + p;
                        const size_t r0 = ((((size_t)(b * 16 + (gm >> 4)) * 4 + (n2 >> 4)) * 16 + (gm & 15)) * 16 + (n2 & 15));
#pragma unroll
                        for (int ai = 0; ai < 2; ++ai) { u32x4 w;
#pragma unroll
                            for (int m = 0; m < 4; ++m) w[m] = cvtpk(acc[ai][bj][m][n][2 * p], acc[ai][bj][m][n][2 * p + 1]);
                            *(u32x4*)(Zt + r0 * 256 + 2 * (n1b + 4 * ai)) = w; }
                    }
        } else {
#pragma unroll
            for (int ai = 0; ai < 2; ++ai)
#pragma unroll
                for (int m = 0; m < 4; ++m) {
                    const int idx = 32 * (u.pm & 1) + 64 * (4 * ai + m) + 16 * wr + fr, b = idx >> 8, nn = idx & 255;
#pragma unroll
                    for (int bj = 0; bj < 2; ++bj)
#pragma unroll
                        for (int n = 0; n < 2; ++n)
#pragma unroll
                            for (int p = 0; p < 2; ++p) { const int gm = gma + 64 * bj + 2 * n + p;
                                *(unsigned*)(ZtC + ((size_t)(b * 256 + gm)) * 512 + 2 * nn) = cvtpk(acc[ai][bj][m][n][2 * p], acc[ai][bj][m][n][2 * p + 1]); }
                }
        }
    }
};

struct EpiRes {
    static constexpr bool PERM = false;
    const float* base_lat; float* out_lat; const float* base_ctx; float* out_ctx; const float* gate; float* part;
    __device__ __forceinline__ void operator()(const f32x4 (&acc)[2][2][4][2], const Unit& u, int wr, int wc, int fr_, int fq_) const {
        int fr = fr_, fq = fq_; asm volatile("" : "+v"(fr), "+v"(fq));
        const int v = u.pm < 32 ? 0 : (u.pm < 64 ? 1 : 2);
        const float* bp; float* op; int row0;
        if (u.pm < 64) { bp = base_lat; op = out_lat; row0 = u.pm * 256 + wr * 64 + fr; } else { bp = base_ctx; op = out_ctx; row0 = (u.pm - 64) * 256 + wr * 64 + fr; }
        const int col0 = u.pn * 256 + wc * 32 + 4 * fq;
        f32x4 gv[2][2];
#pragma unroll
        for (int bj = 0; bj < 2; ++bj)
#pragma unroll
            for (int n = 0; n < 2; ++n) gv[bj][n] = *(const f32x4*)(gate + v * 6144 + col0 + 128 * bj + 16 * n);
#pragma unroll
        for (int ai = 0; ai < 2; ++ai)
#pragma unroll
            for (int m = 0; m < 4; ++m) { const size_t off = (size_t)(row0 + 128 * ai + 16 * m) * DM + col0;
#pragma unroll
                for (int bj = 0; bj < 2; ++bj)
#pragma unroll
                    for (int n = 0; n < 2; ++n) {
                        if (part) { *(f32x4*)(part + (size_t)u.kc * (512 * DM) + off + 128 * bj + 16 * n) = gv[bj][n] * acc[ai][bj][m][n]; }
                        else { const f32x4 bs = *(const f32x4*)(bp + off + 128 * bj + 16 * n); *(f32x4*)(op + off + 128 * bj + 16 * n) = bs + gv[bj][n] * acc[ai][bj][m][n]; } }
                if (m & 1) asm volatile("" ::: "memory"); }
    }
};

__device__ __forceinline__ float dpp_shr1(float v) { return __builtin_bit_cast(float, __builtin_amdgcn_update_dpp(0, __builtin_bit_cast(int, v), 0x111, 0xf, 0xf, true)); }
__device__ __forceinline__ float dpp_shl1(float v) { return __builtin_bit_cast(float, __builtin_amdgcn_update_dpp(0, __builtin_bit_cast(int, v), 0x101, 0xf, 0xf, true)); }

struct EpiUp {
    static constexpr bool PERM = true;
    bf16_t* A2; const float* cw; const float* cb; int Mrows;
    __device__ __forceinline__ void operator()(const f32x4 (&acc)[2][2][4][2], const Unit& u, int wr, int wc, int fr_, int fq_) const {
        int fr = fr_, fq = fq_; asm volatile("" : "+v"(fr), "+v"(fq));
        const int T0 = 252 * u.pm, tokb = T0 - 1 + 126 * wr + 8 * fr;
        const int jg0 = 128 * u.pn + 32 * wc + 8 * fq;
        const int lo = T0 + 126 * wr, hiT = (lo + 126 < Mrows) ? lo + 126 : Mrows;
#pragma unroll
        for (int n = 0; n < 2; ++n) {
            const int jc = jg0 + 4 * n;
            const f32x4 g0 = *(const f32x4*)(cw + jc), g1 = *(const f32x4*)(cw + 2 * DFF + jc), g2 = *(const f32x4*)(cw + 4 * DFF + jc), gb = *(const f32x4*)(cb + jc);
            const f32x4 v0 = *(const f32x4*)(cw + DFF + jc), v1 = *(const f32x4*)(cw + 3 * DFF + jc), v2 = *(const f32x4*)(cw + 5 * DFF + jc), vb = *(const f32x4*)(cb + DFF + jc);
            f32x4 gprev, gnext, vprev, vnext;
#pragma unroll
            for (int j = 0; j < 4; ++j) { gprev[j] = dpp_shr1(acc[1][0][3][n][j]); gnext[j] = dpp_shl1(acc[0][0][0][n][j]); vprev[j] = dpp_shr1(acc[1][1][3][n][j]); vnext[j] = dpp_shl1(acc[0][1][0][n][j]); }
#pragma unroll
            for (int i8 = 0; i8 < 8; ++i8) {
                const int tok = tokb + i8; const int msk = tok < NLAT ? 8191 : 255;
                const bool first = (tok & msk) == 0, lastt = ((tok + 1) & msk) == 0;
                const f32x4 gc = acc[i8 >> 2][0][i8 & 3][n], vc = acc[i8 >> 2][1][i8 & 3][n];
                f32x4 gp = i8 > 0 ? acc[(i8 - 1) >> 2][0][(i8 - 1) & 3][n] : gprev, gn = i8 < 7 ? acc[(i8 + 1) >> 2][0][(i8 + 1) & 3][n] : gnext;
                f32x4 vp = i8 > 0 ? acc[(i8 - 1) >> 2][1][(i8 - 1) & 3][n] : vprev, vn = i8 < 7 ? acc[(i8 + 1) >> 2][1][(i8 + 1) & 3][n] : vnext;
                if (first) { gp = (f32x4){0.f, 0.f, 0.f, 0.f}; vp = gp; }
                if (lastt) { gn = (f32x4){0.f, 0.f, 0.f, 0.f}; vn = gn; }
                const f32x4 cg = g0 * gp + g1 * gc + g2 * gn + gb, cv = v0 * vp + v1 * vc + v2 * vn + vb;
                f32x4 r;
#pragma unroll
                for (int j = 0; j < 4; ++j) r[j] = cg[j] * __builtin_amdgcn_rcpf(1.f + __builtin_amdgcn_exp2f(-LOG2E * cg[j])) * cv[j];
                if (tok >= lo && tok < hiT) { u32x2 w; w.x = cvtpk(r[0], r[1]); w.y = cvtpk(r[2], r[3]); *(u32x2*)(A2 + (size_t)tok * DFF + jc) = w; }
            }
        }
    }
};

struct EpiF1 {
    static constexpr bool PERM = true;
    bf16_t* A2t; const f32x2* tw;
    __device__ __forceinline__ void operator()(const f32x4 (&acc)[2][2][4][2], const Unit& u, int wr, int wc, int fr_, int fq_) const {
        int fr = fr_, fq = fq_; asm volatile("" : "+v"(fr), "+v"(fq));
        const int pn = u.pn, n2hi = pn & 3, gmhi = (pn >> 2) & 15, b = pn >> 6;
        const int n2b = 16 * n2hi + 8 * (fq & 1);
#pragma unroll
        for (int m = 0; m < 4; ++m) {
            const int k1 = 64 * wr + 16 * m + fr, k1grp = k1 >> 2, k1lo = k1 & 3;
#pragma unroll
            for (int n = 0; n < 2; ++n) {
                f32x2 t[4];
#pragma unroll
                for (int j = 0; j < 4; ++j) t[j] = tw[(k1 * (n2b + 4 * n + j)) & 8191];
#pragma unroll
                for (int bj = 0; bj < 2; ++bj) {
                    const int gm = 16 * gmhi + 8 * bj + 2 * wc + (fq >> 1);
                    const f32x4 ar = acc[0][bj][m][n], ai = acc[1][bj][m][n];
                    u32x4 w;
#pragma unroll
                    for (int j = 0; j < 4; ++j) { const float re = ar[j] * t[j].x + ai[j] * t[j].y, im = ai[j] * t[j].x - ar[j] * t[j].y; w[j] = cvtpk(re, im); }
                    *(u32x4*)(A2t + ((size_t)(k1grp * 512 + b * 256 + gm)) * 512 + (k1lo * 64 + n2b + 4 * n) * 2) = w;
                }
                asm volatile("" ::: "memory");
            }
        }
    }
};

struct EpiF2 {
    static constexpr bool PERM = true;
    bf16_t* Y; int mode;
    __device__ __forceinline__ void operator()(const f32x4 (&acc)[2][2][4][2], const Unit& u, int wr, int wc, int fr_, int fq_) const {
        int fr = fr_, fq = fq_; asm volatile("" : "+v"(fr), "+v"(fq));
#pragma unroll
        for (int ai = 0; ai < 2; ++ai)
#pragma unroll
            for (int m = 0; m < 4; ++m) {
                int row;
                if (mode == 0) { const int k1grp = u.pn >> 1, b = u.pn & 1, k = 4 * k1grp + 2 * ai + wr + 128 * (16 * m + fr); row = b * SEQ + k; }
                else row = NLAT + 256 * u.pn + 128 * ai + 64 * wr + 16 * m + fr;
                bf16_t* rowp = Y + (size_t)row * DM + 768 + 32 * wc + 8 * fq;
#pragma unroll
                for (int bj = 0; bj < 2; ++bj) { const f32x4 v0 = acc[ai][bj][m][0], v1 = acc[ai][bj][m][1]; u32x4 w; w.x = cvtpk(v0[0], v0[1]); w.y = cvtpk(v0[2], v0[3]); w.z = cvtpk(v1[0], v1[1]); w.w = cvtpk(v1[2], v1[3]);
                    *(u32x4*)(rowp + 128 * bj) = w; }
            }
    }
};
__device__ __forceinline__ int crow(int r, int hi) { return (r & 3) + 8 * (r >> 2) + 4 * hi; }
typedef short v4i16_t __attribute__((ext_vector_type(4)));
__device__ __forceinline__ bf16x8 vtr2(const LAS unsigned char* p) {
    const s16x4 lo = __builtin_bit_cast(s16x4, __builtin_amdgcn_ds_read_tr16_b64_v4i16((LAS v4i16_t*)p));
    const s16x4 hi = __builtin_bit_cast(s16x4, __builtin_amdgcn_ds_read_tr16_b64_v4i16((LAS v4i16_t*)(p + 1024)));
    return (bf16x8){lo[0], lo[1], lo[2], lo[3], hi[0], hi[1], hi[2], hi[3]};
}
__device__ __forceinline__ int vsub_off(int key, int dch) { return ((key >> 3) * 2 + (dch >> 2)) * 512 + (key & 7) * 64 + (dch & 3) * 16; }

template <bool LOCAL>
__device__ __forceinline__ void na_tile(LAS unsigned char* vl, const LAS float* brow, const bf16_t* __restrict__ P, int krn, bool more, int h, int lane, int q32, int hi, int trb,
                                        const bf16x8 (&qf)[2][4], const unsigned (&mk)[2], f32x16 (&o)[2][2], float (&lsum)[2]) {
    LAS unsigned char* kl = vl + 8192;
    asm volatile("s_waitcnt vmcnt(8)" ::: "memory");
    bf16x8 kf[2][4];
#pragma unroll
    for (int kb = 0; kb < 2; ++kb)
#pragma unroll
        for (int d0 = 0; d0 < 4; ++d0) { const int key = 32 * kb + q32; kf[kb][d0] = *(const LAS bf16x8*)(kl + key * 128 + (((2 * d0 + hi) ^ ((key >> 1) & 7)) * 16)); }
    f32x16 s[2][2];
#pragma unroll
    for (int qb = 0; qb < 2; ++qb)
#pragma unroll
        for (int kb = 0; kb < 2; ++kb) {
            if (LOCAL) { const LAS float* bp = brow + (4 * hi - (32 * qb + q32) + 15) + 32 * kb;
#pragma unroll
                for (int e = 0; e < 16; ++e) s[qb][kb][e] = bp[(e & 3) + 8 * (e >> 2)]; }
            else {
#pragma unroll
                for (int e = 0; e < 16; ++e) s[qb][kb][e] = 0.f; }
#pragma unroll
            for (int d0 = 0; d0 < 4; ++d0) s[qb][kb] = __builtin_amdgcn_mfma_f32_32x32x16_bf16(kf[kb][d0], qf[qb][d0], s[qb][kb], 0, 0, 0);
        }
    if (more) {
        const int kk = lane >> 3, kc = (lane & 7) ^ ((kk >> 1) & 7);
#pragma unroll
        for (int i = 0; i < 8; ++i)
            __builtin_amdgcn_global_load_lds((const unsigned*)(P + (size_t)(krn + 8 * i + kk) * PP + NAK0 + 64 * h + 8 * (kc ^ ((4 * i) & 7))), (LAS unsigned*)(kl + 1024 * i), 16, 0, 0);
    }
#pragma unroll
    for (int qb = 0; qb < 2; ++qb) {
        bf16x8 pf[4];
#pragma unroll
        for (int kb = 0; kb < 2; ++kb) {
            float pe[16];
#pragma unroll
            for (int e = 0; e < 16; ++e) { float p = __builtin_amdgcn_exp2f(s[qb][kb][e]);
                if (LOCAL) { const int msk = ((int)(mk[qb] << (31 - (16 * kb + e)))) >> 31; p = __builtin_bit_cast(float, __builtin_bit_cast(int, p) & msk); }
                pe[e] = p; lsum[qb] += p; }
#pragma unroll
            for (int hf = 0; hf < 2; ++hf) { u32x4 w; w.x = cvtpk(pe[8 * hf + 0], pe[8 * hf + 1]); w.y = cvtpk(pe[8 * hf + 2], pe[8 * hf + 3]); w.z = cvtpk(pe[8 * hf + 4], pe[8 * hf + 5]); w.w = cvtpk(pe[8 * hf + 6], pe[8 * hf + 7]);
                pf[2 * kb + hf] = __builtin_bit_cast(bf16x8, w); }
        }
        if (qb == 0) { if (more) asm volatile("s_waitcnt vmcnt(8)" ::: "memory"); else asm volatile("s_waitcnt vmcnt(0)" ::: "memory"); }
#pragma unroll
        for (int d0 = 0; d0 < 2; ++d0) { bf16x8 vf[4];
#pragma unroll
            for (int ks = 0; ks < 4; ++ks) vf[ks] = vtr2(vl + trb + (4 * ks + d0) * 512);
#pragma unroll
            for (int ks = 0; ks < 4; ++ks) o[qb][d0] = __builtin_amdgcn_mfma_f32_32x32x16_bf16(vf[ks], pf[ks], o[qb][d0], 0, 0, 0); }
    }
    if (more) {
        asm volatile("s_waitcnt lgkmcnt(0)" ::: "memory");
#pragma unroll
        for (int i = 0; i < 8; ++i)
            __builtin_amdgcn_global_load_lds((const unsigned*)(P + (size_t)(krn + 8 * i + ((lane & 31) >> 2)) * PP + NAV0 + 64 * h + 32 * (lane >> 5) + 8 * (lane & 3)), (LAS unsigned*)(vl + 1024 * i), 16, 0, 0);
    }
}
__device__ __forceinline__ void na_unit(LAS unsigned char* lds, const bf16_t* __restrict__ P, bf16_t* __restrict__ Y, const float* __restrict__ rpb, int qrow0, int b, int r, int wid, int lane_in) {
    int lane = lane_in; asm volatile("" : "+v"(lane));
    const int h = wid, q32 = lane & 31, hi = lane >> 5;
    LAS unsigned char* vl = lds + wid * 17408;
    LAS float* btab = (LAS float*)(vl + 16384);
    int rs = 0;
    unsigned mk[2] = {0u, 0u};
    if (r >= 0) {
        rs = r - 4; rs = rs < 0 ? 0 : (rs > 120 ? 120 : rs);
#pragma unroll
        for (int i = 0; i < 4; ++i) { const int e = lane + 64 * i, kt = e >> 5, rel = e & 31, dr = rs + kt - r + 7; btab[e] = rel < 31 ? rpb[(h * 15 + dr) * 31 + rel] * LOG2E : 0.f; }
#pragma unroll
        for (int qb = 0; qb < 2; ++qb) { const int c = 32 * qb + q32; int cs = c - 8; cs = cs < 0 ? 0 : (cs > 48 ? 48 : cs);
#pragma unroll
            for (int bit = 0; bit < 32; ++bit) { const int kc = 32 * (bit >> 4) + crow(bit & 15, hi); if ((unsigned)(kc - cs) < 16u) mk[qb] |= (1u << bit); } }
    }
    bf16x8 qf[2][4];
#pragma unroll
    for (int qb = 0; qb < 2; ++qb)
#pragma unroll
        for (int d0 = 0; d0 < 4; ++d0) qf[qb][d0] = *(const bf16x8*)(P + (size_t)(qrow0 + 32 * qb + q32) * PP + NAQ0 + 64 * h + 16 * d0 + 8 * hi);
    f32x16 o[2][2]; float lsum[2] = {0.f, 0.f};
#pragma unroll
    for (int a = 0; a < 2; ++a)
#pragma unroll
        for (int d = 0; d < 2; ++d)
#pragma unroll
            for (int e = 0; e < 16; ++e) o[a][d][e] = 0.f;
    const int trb = (4 * hi + ((lane & 15) >> 2)) * 64 + (((lane >> 4) & 1) * 16 + (lane & 3) * 4) * 2;
    const int nloc = (r >= 0) ? 8 : 0, ntiles = nloc + 4;
#define NA_ROW0(t_) ((t_) < nloc ? b * SEQ + 64 * (rs + (t_)) : NLAT + b * CTXL + 64 * ((t_) - nloc))
    {
        const int kr0 = NA_ROW0(0); const int kk = lane >> 3, kc = (lane & 7) ^ ((kk >> 1) & 7);
#pragma unroll
        for (int i = 0; i < 8; ++i)
            __builtin_amdgcn_global_load_lds((const unsigned*)(P + (size_t)(kr0 + 8 * i + kk) * PP + NAK0 + 64 * h + 8 * (kc ^ ((4 * i) & 7))), (LAS unsigned*)(vl + 8192 + 1024 * i), 16, 0, 0);
#pragma unroll
        for (int i = 0; i < 8; ++i)
            __builtin_amdgcn_global_load_lds((const unsigned*)(P + (size_t)(kr0 + 8 * i + ((lane & 31) >> 2)) * PP + NAV0 + 64 * h + 32 * (lane >> 5) + 8 * (lane & 3)), (LAS unsigned*)(vl + 1024 * i), 16, 0, 0);
    }
    for (int t = 0; t < nloc; ++t) na_tile<true>(vl, btab + t * 32, P, NA_ROW0(t + 1), true, h, lane, q32, hi, trb, qf, mk, o, lsum);
    for (int t = nloc; t < ntiles; ++t) na_tile<false>(vl, btab, P, NA_ROW0(t + 1), t + 1 < ntiles, h, lane, q32, hi, trb, qf, mk, o, lsum);
#undef NA_ROW0
#pragma unroll
    for (int qb = 0; qb < 2; ++qb) {
        const float l = sum_xor32(lsum[qb]); const float rl = 1.f / l;
        bf16_t* yp = Y + (size_t)(qrow0 + 32 * qb + q32) * DM + 64 * h + 4 * hi;
#pragma unroll
        for (int d0 = 0; d0 < 2; ++d0)
#pragma unroll
            for (int g4 = 0; g4 < 4; ++g4) { u32x2 w; w.x = cvtpk(o[qb][d0][4 * g4] * rl, o[qb][d0][4 * g4 + 1] * rl); w.y = cvtpk(o[qb][d0][4 * g4 + 2] * rl, o[qb][d0][4 * g4 + 3] * rl);
                *(u32x2*)(yp + 32 * d0 + 8 * g4) = w; }
    }
}

#define DU_ROW(t_) ((size_t)(((t_) < 128 ? b * SEQ + 64 * (t_) : NLAT + b * CTXL + 64 * ((t_) - 128)) + skey) * PP)
#define DU_TILE(BUF) do { \
        bf16x8 p1[4], p2[4]; \
        _Pragma("unroll") for (int c = 0; c < 2; ++c) { \
            _Pragma("unroll") for (int kb = 0; kb < 2; ++kb) { \
                const int key = 32 * kb + q32; \
                f32x16 s; \
                _Pragma("unroll") for (int e = 0; e < 16; ++e) s[e] = 0.f; \
                _Pragma("unroll") for (int d0 = 0; d0 < 2; ++d0) { const int ch = 4 * c + 2 * d0 + hi; const bf16x8 kf = *(const LAS bf16x8*)((BUF) + key * 128 + ((ch ^ ((key >> 1) & 7)) * 16)); \
                    s = __builtin_amdgcn_mfma_f32_32x32x16_bf16(kf, qf[c][d0], s, 0, 0, 0); } \
                float pe[16]; float ls = 0.f; \
                _Pragma("unroll") for (int e = 0; e < 16; ++e) { pe[e] = __builtin_amdgcn_exp2f(s[e]); ls += pe[e]; } \
                if (c == 0) l1 += ls; else l2 += ls; \
                _Pragma("unroll") for (int hf = 0; hf < 2; ++hf) { u32x4 w; w.x = cvtpk(pe[8 * hf + 0], pe[8 * hf + 1]); w.y = cvtpk(pe[8 * hf + 2], pe[8 * hf + 3]); w.z = cvtpk(pe[8 * hf + 4], pe[8 * hf + 5]); w.w = cvtpk(pe[8 * hf + 6], pe[8 * hf + 7]); \
                    if (c == 0) p1[2 * kb + hf] = __builtin_bit_cast(bf16x8, w); else p2[2 * kb + hf] = __builtin_bit_cast(bf16x8, w); } \
            } \
        } \
        _Pragma("unroll") for (int d0 = 0; d0 < 2; ++d0) \
            _Pragma("unroll") for (int ks = 0; ks < 4; ++ks) { const bf16x8 vf = vtr2((BUF) + trb + (4 * ks + d0) * 512); \
                o1[d0] = __builtin_amdgcn_mfma_f32_32x32x16_bf16(vf, p1[ks], o1[d0], 0, 0, 0); o2[d0] = __builtin_amdgcn_mfma_f32_32x32x16_bf16(vf, p2[ks], o2[d0], 0, 0, 0); } \
    } while (0)
__device__ __forceinline__ void diff_unit(LAS unsigned char* lds, const bf16_t* __restrict__ P, bf16_t* __restrict__ Y, const float* __restrict__ subg, int qrow0, int b, int h, int t0, int t1, float lam, float oscale, int tid_in) {
    int tid = tid_in; asm volatile("" : "+v"(tid));
    const int lane = tid & 63, wid = tid >> 6, q32 = lane & 31, hi = lane >> 5;
    const int qrow = qrow0 + 32 * wid + q32;
    bf16x8 qf[2][2];
#pragma unroll
    for (int c = 0; c < 2; ++c)
#pragma unroll
        for (int d0 = 0; d0 < 2; ++d0) qf[c][d0] = *(const bf16x8*)(P + (size_t)qrow * PP + DQ0 + 64 * h + 32 * c + 16 * d0 + 8 * hi);
    const int trb = 8192 + (4 * hi + ((lane & 15) >> 2)) * 64 + (((lane >> 4) & 1) * 16 + (lane & 3) * 4) * 2;
    f32x16 o1[2], o2[2]; float l1 = 0.f, l2 = 0.f;
#pragma unroll
    for (int d = 0; d < 2; ++d)
#pragma unroll
        for (int e = 0; e < 16; ++e) { o1[d][e] = 0.f; o2[d][e] = 0.f; }
    const int kkey = 8 * wid + (lane >> 3), kch = (lane & 7) ^ ((kkey >> 1) & 7);
    const size_t koff = (size_t)kkey * PP + DK0 + 64 * h + 8 * kch, voff = (size_t)(8 * wid + ((lane & 31) >> 2)) * PP + DV0 + 64 * h + 32 * (lane >> 5) + 8 * (lane & 3);
#define DU_DMA(tt, sl) do { const size_t r_ = (size_t)((tt) < 128 ? b * SEQ + 64 * (tt) : NLAT + b * CTXL + 64 * ((tt) - 128)) * PP; \
        __builtin_amdgcn_global_load_lds((const unsigned*)(P + r_ + koff), (LAS unsigned*)(lds + (sl) * 16384 + wid * 1024), 16, 0, 0); \
        __builtin_amdgcn_global_load_lds((const unsigned*)(P + r_ + voff), (LAS unsigned*)(lds + (sl) * 16384 + 8192 + wid * 1024), 16, 0, 0); } while (0)
    DU_DMA(t0, 0); DU_DMA(t0 + 1, 1);
    asm volatile("s_waitcnt vmcnt(2)" ::: "memory"); __builtin_amdgcn_s_barrier(); asm volatile("" ::: "memory");
    int slot = 0;
    for (int t = t0; t < t1; ++t) {
        const int s2 = slot == 0 ? 2 : slot - 1;
        if (t + 2 < t1) DU_DMA(t + 2, s2);
        { LAS unsigned char* buf = lds + slot * 16384; DU_TILE(buf); }
        if (t + 2 < t1) asm volatile("s_waitcnt vmcnt(2)" ::: "memory"); else asm volatile("s_waitcnt vmcnt(0)" ::: "memory");
        __builtin_amdgcn_s_barrier(); asm volatile("" ::: "memory");
        slot = slot == 2 ? 0 : slot + 1;
    }
#undef DU_DMA
    l1 = sum_xor32(l1); l2 = sum_xor32(l2);
    const float r1 = 1.f / l1, r2 = lam / l2;
    float ss = 0.f;
#pragma unroll
    for (int d0 = 0; d0 < 2; ++d0)
#pragma unroll
        for (int e = 0; e < 16; ++e) { const float v = o1[d0][e] * r1 - o2[d0][e] * r2; o1[d0][e] = v; ss += v * v; }
    ss = sum_xor32(ss);
    const float rstd = __builtin_amdgcn_rsqf(ss * (1.f / 64.f) + EPS) * oscale;
    bf16_t* yp = Y + (size_t)qrow * DM + 512 + 64 * h + 4 * hi;
    const float* sg = subg; asm volatile("" : "+s"(sg));
#pragma unroll
    for (int d0 = 0; d0 < 2; ++d0)
#pragma unroll
        for (int g4 = 0; g4 < 4; ++g4) { const f32x4 gg = *(const f32x4*)(sg + 32 * d0 + 8 * g4 + 4 * hi);
            u32x2 w; w.x = cvtpk(o1[d0][4 * g4] * rstd * gg[0], o1[d0][4 * g4 + 1] * rstd * gg[1]); w.y = cvtpk(o1[d0][4 * g4 + 2] * rstd * gg[2], o1[d0][4 * g4 + 3] * rstd * gg[3]);
            *(u32x2*)(yp + 32 * d0 + 8 * g4) = w; }
}
#undef DU_TILE
#undef DU_ROW

__device__ __forceinline__ float fadd_s(float a, float b) { float r; asm("v_add_f32_e32 %0, %1, %2" : "=v"(r) : "v"(a), "v"(b)); return r; }
#define DF_EXP(S0, S1, PF, LSUM) do { \
    _Pragma("unroll") for (int kb_ = 0; kb_ < 2; ++kb_) { float pe_[16]; \
        _Pragma("unroll") for (int e_ = 0; e_ < 16; ++e_) { pe_[e_] = __builtin_amdgcn_exp2f(kb_ == 0 ? S0[e_] : S1[e_]); LSUM += pe_[e_]; asm volatile("" : "+v"(LSUM)); } \
        _Pragma("unroll") for (int hf_ = 0; hf_ < 2; ++hf_) { u32x4 w_; w_.x = cvtpk(pe_[8 * hf_ + 0], pe_[8 * hf_ + 1]); w_.y = cvtpk(pe_[8 * hf_ + 2], pe_[8 * hf_ + 3]); w_.z = cvtpk(pe_[8 * hf_ + 4], pe_[8 * hf_ + 5]); w_.w = cvtpk(pe_[8 * hf_ + 6], pe_[8 * hf_ + 7]); \
            PF[2 * kb_ + hf_] = __builtin_bit_cast(bf16x8, w_); } } } while (0)
#define DF_S2(C, DST0, DST1, KBUF) do { bf16x8 kf_[2][2]; \
    _Pragma("unroll") for (int kb_ = 0; kb_ < 2; ++kb_) _Pragma("unroll") for (int d0_ = 0; d0_ < 2; ++d0_) { const int key_ = 32 * kb_ + q32; \
        kf_[kb_][d0_] = *(const LAS bf16x8*)((KBUF) + key_ * 128 + (((4 * (C) + 2 * d0_ + hi) ^ ((key_ >> 1) & 7)) * 16)); } \
    DST0 = __builtin_amdgcn_mfma_f32_32x32x16_bf16(kf_[0][0], qf[C][0], Z, 0, 0, 0); DST1 = __builtin_amdgcn_mfma_f32_32x32x16_bf16(kf_[1][0], qf[C][0], Z, 0, 0, 0); \
    DST0 = __builtin_amdgcn_mfma_f32_32x32x16_bf16(kf_[0][1], qf[C][1], DST0, 0, 0, 0); DST1 = __builtin_amdgcn_mfma_f32_32x32x16_bf16(kf_[1][1], qf[C][1], DST1, 0, 0, 0); } while (0)
#define DF_PV(O, PF, VBUF) do { bf16x8 vf_[2][4]; \
    _Pragma("unroll") for (int d0_ = 0; d0_ < 2; ++d0_) _Pragma("unroll") for (int ks_ = 0; ks_ < 4; ++ks_) vf_[d0_][ks_] = vtr2((VBUF) + trb + (4 * ks_ + d0_) * 512); \
    _Pragma("unroll") for (int ks_ = 0; ks_ < 4; ++ks_) _Pragma("unroll") for (int d0_ = 0; d0_ < 2; ++d0_) O[d0_] = __builtin_amdgcn_mfma_f32_32x32x16_bf16(vf_[d0_][ks_], PF[ks_], O[d0_], 0, 0, 0); } while (0)
__device__ __forceinline__ void diff_unit2(LAS unsigned char* lds, const bf16_t* __restrict__ P, bf16_t* __restrict__ Y, const float* __restrict__ subg, int qrow0, int b, int h, int t0, int t1, float lam, float oscale, int tid_in) {
    int tid = tid_in; asm volatile("" : "+v"(tid));
    const int lane = tid & 63, wid = tid >> 6, q32 = lane & 31, hi = lane >> 5;
    const int qrow = qrow0 + 32 * wid + q32;
    bf16x8 qf[2][2];
#pragma unroll
    for (int c = 0; c < 2; ++c)
#pragma unroll
        for (int d0 = 0; d0 < 2; ++d0) qf[c][d0] = *(const bf16x8*)(P + (size_t)qrow * PP + DQ0 + 64 * h + 32 * c + 16 * d0 + 8 * hi);
    const int skey = tid >> 3, sch = tid & 7;
    const int kdst = skey * 128 + ((sch ^ ((skey >> 1) & 7)) * 16), vdst = 16384 + vsub_off(skey, sch);
    const int trb = (4 * hi + ((lane & 15) >> 2)) * 64 + (((lane >> 4) & 1) * 16 + (lane & 3) * 4) * 2;
    f32x16 Z; { float z0 = 0.f; asm volatile("" : "+v"(z0));
#pragma unroll
    for (int e = 0; e < 16; ++e) Z[e] = z0; }
    asm volatile("" : "+v"(Z));
    f32x16 o1[2], o2[2]; float l1 = 0.f, l2 = 0.f;
#pragma unroll
    for (int d = 0; d < 2; ++d) { o1[d] = Z; o2[d] = Z; }
    const bf16_t* kg = P + DK0 + 64 * h + 8 * sch; const bf16_t* vg = P + DV0 + 64 * h + 8 * sch;
#define DF_ROW(t_) ((size_t)(((t_) < 128 ? b * SEQ + 64 * (t_) : NLAT + b * CTXL + 64 * ((t_) - 128)) + skey) * PP)
    u32x4 rk, rv;
    rk = *(const u32x4*)(kg + DF_ROW(t0)); rv = *(const u32x4*)(vg + DF_ROW(t0));
    *(LAS u32x4*)(lds + kdst) = rk; *(LAS u32x4*)(lds + vdst) = rv;
    rk = *(const u32x4*)(kg + DF_ROW(t0 + 1));
    *(LAS u32x4*)(lds + 8192 + kdst) = rk;
    __syncthreads();
    f32x16 sA0, sA1, sB0, sB1; bf16x8 p1[4], p2[4];
    DF_S2(0, sA0, sA1, lds); DF_S2(1, sB0, sB1, lds);
    __syncthreads();
    DF_EXP(sA0, sA1, p1, l1);
    for (int t = t0; t < t1; ++t) {
        const int it = t - t0; const bool more = (t + 1 < t1);
        LAS unsigned char* kb1 = lds + ((it + 1) & 1) * 8192;
        LAS unsigned char* vb0 = lds + 16384 + (it & 1) * 8192;
        if (t + 2 < t1) rk = *(const u32x4*)(kg + DF_ROW(t + 2));
        if (more) rv = *(const u32x4*)(vg + DF_ROW(t + 1));
        __builtin_amdgcn_sched_barrier(0);
        if (more) { DF_S2(0, sA0, sA1, kb1); }
        DF_PV(o1, p1, vb0);
        DF_EXP(sB0, sB1, p2, l2);
        __builtin_amdgcn_sched_barrier(0);
        DF_PV(o2, p2, vb0);
        if (more) { DF_S2(1, sB0, sB1, kb1); DF_EXP(sA0, sA1, p1, l1); }
        __builtin_amdgcn_sched_barrier(0);
        if (t + 2 < t1) *(LAS u32x4*)(lds + (it & 1) * 8192 + kdst) = rk;
        if (more) *(LAS u32x4*)(lds + ((it + 1) & 1) * 8192 + vdst) = rv;
        __syncthreads();
    }
#undef DF_ROW
    l1 = sum_xor32(l1); l2 = sum_xor32(l2);
    const float r1 = 1.f / l1, r2 = lam / l2;
    float ss = 0.f;
#pragma unroll
    for (int d0 = 0; d0 < 2; ++d0)
#pragma unroll
        for (int e = 0; e < 16; ++e) { const float v = o1[d0][e] * r1 - o2[d0][e] * r2; o1[d0][e] = v; ss += v * v; }
    ss = sum_xor32(ss);
    const float rstd = __builtin_amdgcn_rsqf(ss * (1.f / 64.f) + EPS) * oscale;
    bf16_t* yp = Y + (size_t)qrow * DM + 512 + 64 * h + 4 * hi;
    const float* sg = subg; asm volatile("" : "+s"(sg));
#pragma unroll
    for (int d0 = 0; d0 < 2; ++d0)
#pragma unroll
        for (int g4 = 0; g4 < 4; ++g4) { const f32x4 gg = *(const f32x4*)(sg + 32 * d0 + 8 * g4 + 4 * hi);
            u32x2 w; w.x = cvtpk(o1[d0][4 * g4] * rstd * gg[0], o1[d0][4 * g4 + 1] * rstd * gg[1]); w.y = cvtpk(o1[d0][4 * g4 + 2] * rstd * gg[2], o1[d0][4 * g4 + 3] * rstd * gg[3]);
            *(u32x2*)(yp + 32 * d0 + 8 * g4) = w; }
}
constexpr size_t MiB = 1u << 20;
constexpr size_t WS_MOD = 0, WS_LAM = 160 * 1024, WS_BAR = 176 * 1024, WS_ROPE = 192 * 1024, WS_TW = 256 * 1024, WS_M1 = 384 * 1024, WS_M2 = 512 * 1024, WS_MC = 768 * 1024;
constexpr size_t WS_W = 1 * MiB, W_LAYER = 24 * MiB, WO_IN = 0, WO_OUT = 5632 * 1024, WO_UP = WO_OUT + 2 * MiB, WO_DN = WO_UP + 11 * MiB;
constexpr size_t WS_XC = 49 * MiB, WS_XN = 51 * MiB, WS_P = 85 * MiB, WS_ZT = 160 * MiB, WS_ZTC = 176 * MiB, WS_A2T = 177 * MiB, WS_Y = 193 * MiB, WS_A2 = 85 * MiB, WS_PART = 228 * MiB, WS_END = 252 * MiB;
static_assert(WO_DN + (size_t)1024 * 2816 * 2 <= W_LAYER, "weights");
static_assert(WS_XN + (size_t)(1 + MT + 256) * DM * 2 <= WS_P && WS_P + (size_t)MT * PP * 2 <= WS_ZT && WS_A2 + (size_t)MT * DFF * 2 <= WS_Y && WS_Y + (size_t)MT * DM * 2 <= WS_PART && WS_PART + (size_t)11 * 512 * DM * 4 <= WS_END, "ws map");

struct Args { const float* in[22]; float* out; unsigned char* ws; };

__device__ __forceinline__ void tr_item(const float* __restrict__ src, int ld, int k0, int c0, bf16_t* __restrict__ dst, int dK, int r0, bool perm, LAS float* scr, int lane) {
#pragma unroll 8
    for (int i = 0; i < 32; ++i) { const int kk = 2 * i + (lane >> 5); scr[kk * 33 + (lane & 31)] = src[(size_t)(k0 + kk) * ld + c0 + (lane & 31)]; }
    const int c = lane & 7;
#pragma unroll
    for (int j = 0; j < 4; ++j) { const int n = (lane >> 3) + 8 * j; const int sn = perm ? dimperm(n) : n; const LAS float* s = scr + (8 * c) * 33 + sn;
        u32x4 o; o.x = cvtpk(s[0 * 33], s[1 * 33]); o.y = cvtpk(s[2 * 33], s[3 * 33]); o.z = cvtpk(s[4 * 33], s[5 * 33]); o.w = cvtpk(s[6 * 33], s[7 * 33]);
        *(u32x4*)(dst + (size_t)(r0 + n) * dK + k0 + 8 * c) = o; }
}

__device__ __forceinline__ void tr_item64(const float* __restrict__ src, int ld, int k0, int c0, bf16_t* __restrict__ dst, int dK, int ra, int rb, bool perm, LAS float* scr, int lane) {
    f32x4 v[16];
    const float* sp = src + (size_t)(k0 + (lane >> 4)) * ld + c0 + 4 * (lane & 15);
#pragma unroll
    for (int i = 0; i < 16; ++i) v[i] = *(const f32x4*)(sp + (size_t)(4 * i) * ld);
#pragma unroll
    for (int i = 0; i < 16; ++i) { LAS float* w = scr + (4 * i + (lane >> 4)) * 65 + 4 * (lane & 15); w[0] = v[i][0]; w[1] = v[i][1]; w[2] = v[i][2]; w[3] = v[i][3]; }
    const int c = lane & 7;
#pragma unroll
    for (int j = 0; j < 8; ++j) { const int n = (lane >> 3) + 8 * j, i32 = n & 31; const int sn = (n & 32) + (perm ? dimperm(i32) : i32); const LAS float* s = scr + (8 * c) * 65 + sn;
        u32x4 o; o.x = cvtpk(s[0 * 65], s[1 * 65]); o.y = cvtpk(s[2 * 65], s[3 * 65]); o.z = cvtpk(s[4 * 65], s[5 * 65]); o.w = cvtpk(s[6 * 65], s[7 * 65]);
        *(u32x4*)(dst + (size_t)((n < 32 ? ra : rb) + i32) * dK + k0 + 8 * c) = o; }
}

__device__ __forceinline__ float silu_f(float x) { return x / (1.f + __expf(-x)); }

__device__ __forceinline__ void prep_phase(const Args& a, LAS unsigned char* lds, int tid_in, int bx, int G) {
    int tid = tid_in; asm volatile("" : "+v"(tid));
    unsigned char* ws = a.ws;
    const int lane = tid & 63, wave = __builtin_amdgcn_readfirstlane(tid >> 6);
#ifndef REP_PB
#define REP_PB 1
#endif
#ifndef REP_PT
#define REP_PT 1
#endif
#ifndef REP_PX
#define REP_PX 1
#endif
    for (int rp = 0; rp < REP_PB; ++rp) {
    const int nslots = (G == 256) ? 2 : (448 + G - 1) / G;
    for (int slot = 0; slot < nslots; ++slot) {
        int it;
        if (G == 256) { if (bx < 128) it = slot == 0 ? bx : (bx < 64 ? 128 + bx : -1); else it = slot == 0 ? 320 + (bx - 128) : 192 + (bx - 128); }
        else { it = bx + slot * G; if (it >= 448) it = -1; }
        if (it < 0) continue;
        __syncthreads();
        if (it < 192) {
            const int l = it / 96, n0 = 64 * (it % 96);
            LAS float* sv = (LAS float*)lds; LAS float* red = sv + 3072;
            for (int e = tid; e < 3072; e += 512) { const int v = e >> 10, k = e & 1023; sv[e] = silu_f(v < 2 ? a.in[1][v * 1024 + k] : a.in[3][k]); }
            __syncthreads();
            const int cq = tid & 15, kg = tid >> 4;
            f32x4 ac[3] = {{0.f, 0.f, 0.f, 0.f}, {0.f, 0.f, 0.f, 0.f}, {0.f, 0.f, 0.f, 0.f}};
            const float* wp = a.in[4] + (size_t)l * 1024 * 6144 + n0 + 4 * cq;
#pragma unroll 8
            for (int i = 0; i < 32; ++i) { const int k = kg + 32 * i; const f32x4 w = *(const f32x4*)(wp + (size_t)k * 6144); ac[0] += w * sv[k]; ac[1] += w * sv[1024 + k]; ac[2] += w * sv[2048 + k]; }
#pragma unroll
            for (int v = 0; v < 3; ++v)
#pragma unroll
                for (int e = 0; e < 4; ++e) red[(kg * 16 + cq) * 12 + v * 4 + e] = ac[v][e];
            __syncthreads();
            if (tid < 192) { const int v = tid >> 6, n = tid & 63; float s = a.in[5][l * 6144 + n0 + n];
                for (int g = 0; g < 32; ++g) s += red[(g * 16 + (n >> 2)) * 12 + v * 4 + (n & 3)];
                ((float*)(ws + WS_MOD))[(l * 3 + v) * 6144 + n0 + n] = s; }
            asm volatile("s_waitcnt vmcnt(0)" ::: "memory"); __syncthreads();
            if (tid == 0) { __builtin_amdgcn_fence(__ATOMIC_RELEASE, "agent"); asm volatile("s_waitcnt vmcnt(0)" ::: "memory"); xb_add((unsigned*)(ws + WS_BAR) + 3648, 1u); }
        } else if (it < 320) {
            const int q = it - 192, l = q >> 6, g = (q >> 4) & 3, k0 = 64 * (q & 15);
            LAS float* wt = (LAS float*)lds; LAS float* ct = wt + 64 * 65; LAS float* st = ct + 64;
            for (int e = tid; e < 4096; e += 512) { const int k = e >> 6, j = e & 63; wt[k * 65 + j] = a.in[7][((size_t)l * 1024 + k0 + k) * INW + FN0 + 64 * g + j]; }
            if (tid < 64) { ct[tid] = cospif((float)tid / 32.f) * 0.125f; st[tid] = -sinpif((float)tid / 32.f) * 0.125f; }
            __syncthreads();
            bf16_t* dst = (bf16_t*)(ws + WS_W + l * W_LAYER + WO_IN);
            {
                const int k = lane, c = wave & 1, m0 = wave >> 1;
                const float tl = c ? st[lane] : ct[lane];
                float s[16];
#pragma unroll
                for (int i = 0; i < 16; ++i) s[i] = 0.f;
#pragma unroll 4
                for (int j = 0; j < 64; ++j) { const float w = wt[k * 65 + j];
#pragma unroll
                    for (int i = 0; i < 16; ++i) s[i] += w * __builtin_bit_cast(float, __builtin_amdgcn_readlane(__builtin_bit_cast(int, tl), ((m0 + 4 * i) * j) & 63)); }
#pragma unroll
                for (int i = 0; i < 16; ++i) dst[(size_t)(2304 + 128 * g + wave + 8 * i) * 1024 + k0 + k] = f2bf(s[i]);
            }
        } else {
            const int q = it - 320, l = q >> 6, n0 = 16 * (q & 63);
            LAS float* wo = (LAS float*)lds; LAS float* wf = wo + 256 * 20;
            for (int e = tid; e < 4096; e += 512) { const int j = e >> 4, nn = e & 15; wo[j * 20 + nn] = a.in[16][((size_t)l * 1024 + 768 + j) * 1024 + n0 + nn]; }
            const int i = tid & 255, nh = tid >> 8;
            float acc[8];
#pragma unroll
            for (int e = 0; e < 8; ++e) acc[e] = 0.f;
            for (int j0 = 0; j0 < 256; j0 += 32) {
                __syncthreads();
                for (int e = tid; e < 8192; e += 512) { const int ii = e >> 5, jj = e & 31; wf[ii * 33 + jj] = a.in[15][((size_t)l * 256 + ii) * 256 + j0 + jj]; }
                __syncthreads();
                for (int jj = 0; jj < 32; ++jj) { const float w = wf[i * 33 + jj]; const LAS f32x4* wr_ = (const LAS f32x4*)(wo + (j0 + jj) * 20 + 8 * nh);
#pragma unroll
                    for (int e4 = 0; e4 < 2; ++e4) { const f32x4 wv = wr_[e4];
#pragma unroll
                        for (int e = 0; e < 4; ++e) acc[4 * e4 + e] += w * wv[e]; } }
            }
            bf16_t* dst = (bf16_t*)(ws + WS_W + l * W_LAYER + WO_OUT);
#pragma unroll
            for (int e = 0; e < 8; ++e) dst[(size_t)(n0 + 8 * nh + e) * 1024 + 768 + i] = f2bf(acc[e]);
        }
    }
    }
    __syncthreads();
    {
        LAS float* scr = (LAS float*)(lds + wave * 16640);
        const int gw = bx * 8 + wave, NGW = G * 8;
        constexpr int I_IN = 16 * 36, I_OUT = 12 * 16, I_UP = 16 * 88, I_DN = 44 * 16, I_L = I_IN + I_OUT + I_UP + I_DN;
        const bool heavy = (G == 256) && bx >= 128;
        constexpr int HV_N = 2048;
        const int it0 = (G != 256) ? gw : (heavy ? gw - 1024 : HV_N + (1023 - gw)), itS = (G != 256) ? NGW : 1024, itE = (G != 256) ? 2 * I_L : (heavy ? HV_N : 2 * I_L);
        for (int rp = 0; rp < REP_PT; ++rp)
        for (int it = it0; it < itE; it += itS) {
            const int l = it / I_L; int r = it % I_L;
            unsigned char* wl = ws + WS_W + l * W_LAYER;
            if (r < I_IN) { const int kb = r / 36, sb = r % 36, pn = sb >> 2, wc = sb & 3;
                tr_item64(a.in[7] + (size_t)l * 1024 * INW, INW, 64 * kb, 256 * pn + 64 * wc, (bf16_t*)(wl + WO_IN), 1024, 256 * pn + 32 * wc, 256 * pn + 128 + 32 * wc, pn == 6 || pn == 7, scr, lane); continue; }
            r -= I_IN;
            if (r < I_OUT) { const int kb = r / 16, nb = r % 16;
                tr_item64(a.in[16] + (size_t)l * 1024 * 1024, 1024, 64 * kb, 64 * nb, (bf16_t*)(wl + WO_OUT), 1024, 64 * nb, 64 * nb + 32, false, scr, lane); continue; }
            r -= I_OUT;
            if (r < I_UP) { const int kb = r / 88, sb = r % 88, half = sb / 44, s = sb % 44; const int d0 = 256 * (s >> 1) + 128 * half + 64 * (s & 1);
                tr_item64(a.in[18] + (size_t)l * 1024 * 5632, 5632, 64 * kb, half * DFF + 64 * s, (bf16_t*)(wl + WO_UP), 1024, d0, d0 + 32, false, scr, lane); continue; }
            r -= I_UP;
            { const int kb = r / 16, nb = r % 16;
                tr_item64(a.in[21] + (size_t)l * DFF * 1024, 1024, 64 * kb, 64 * nb, (bf16_t*)(wl + WO_DN), DFF, 64 * nb, 64 * nb + 32, false, scr, lane); }
        }
    }
    for (int rp = 0; rp < REP_PX; ++rp) {
        const int gt = bx * 512 + tid, NT = G * 512;
        f32x2* rope = (f32x2*)(ws + WS_ROPE);
        for (int e = gt; e < 1024; e += NT) { const int pos = e >> 3, f = e & 7; const float inv = exp2f(-(float)f * (13.287712379549449f / 8.f)); const float ang = (float)pos * inv;
            const double rev = (double)ang * 0.15915494309189535; const float fr = (float)(rev - floor(rev)); rope[e] = (f32x2){cospif(2.f * fr), sinpif(2.f * fr)}; }
        f32x2* tw = (f32x2*)(ws + WS_TW);
        for (int e = gt; e < 8192; e += NT) { const float x = (float)e / 4096.f; tw[e] = (f32x2){cospif(x), sinpif(x)}; }
        bf16_t* m1 = (bf16_t*)(ws + WS_M1);
        for (int e = gt; e < 65536; e += NT) { const int rho = e >> 8, kk = e & 255, cp = rho >> 7, k1 = rho & 127, n1 = kk >> 1, c = kk & 1; const float x = (float)((k1 * n1) & 127) / 64.f;
            const float cs = cospif(x) * 0.08838834764831845f, sn = sinpif(x) * 0.08838834764831845f; m1[e] = f2bf(cp == 0 ? (c == 0 ? cs : sn) : (c == 0 ? -sn : cs)); }
        bf16_t* m2 = (bf16_t*)(ws + WS_M2);
        for (int e = gt; e < 131072; e += NT) { const int rho = e >> 9, kk = e & 511, k1lo = rho >> 6, k2 = rho & 63, kl2 = kk >> 7, n2 = (kk >> 1) & 63, c = kk & 1; const float x = (float)((k2 * n2) & 63) / 32.f;
            m2[e] = f2bf(kl2 == k1lo ? (c == 0 ? cospif(x) : sinpif(x)) * 0.125f : 0.f); }
        bf16_t* mc = (bf16_t*)(ws + WS_MC);
        for (int e = gt; e < 131072; e += NT) { const int k = e >> 9, kk = e & 511, n = kk >> 1, c = kk & 1; const float x = (float)((k * n) & 255) / 128.f; mc[e] = f2bf((c == 0 ? cospif(x) : sinpif(x)) * 0.0625f); }
        if (gt < 2) { const float* dl = a.in[13] + gt * 128; float s1 = 0.f, s2 = 0.f; for (int i = 0; i < 32; ++i) { s1 += dl[i] * dl[32 + i]; s2 += dl[64 + i] * dl[96 + i]; }
            const float li = 0.8f - 0.6f * expf(-0.3f * (float)gt); float* lm = (float*)(ws + WS_LAM); lm[2 * gt] = expf(s1) - expf(s2) + li; lm[2 * gt + 1] = 1.f - li; }
    }
}

__device__ __forceinline__ void norm_row(const float* __restrict__ xr, bf16_t* __restrict__ orow, const f32x4 (&gs)[4], const f32x4 (&sh)[4], int lane, float* cp, const float* part, int nparts) {
    f32x4 v[4]; float s = 0.f;
#pragma unroll
    for (int j = 0; j < 4; ++j) { v[j] = *(const f32x4*)(xr + 4 * lane + 256 * j);
        for (int p = 0; p < nparts; ++p) v[j] += *(const f32x4*)(part + (size_t)p * (512 * DM) + 4 * lane + 256 * j);
        if (cp) *(f32x4*)(cp + 4 * lane + 256 * j) = v[j]; s += (v[j][0] * v[j][0] + v[j][1] * v[j][1]) + (v[j][2] * v[j][2] + v[j][3] * v[j][3]); }
    s += SWZ_XOR(s, 1); s += SWZ_XOR(s, 2); s += SWZ_XOR(s, 4); s += SWZ_XOR(s, 8); s += SWZ_XOR(s, 16); s = sum_xor32(s);
    const float rstd = __builtin_amdgcn_rsqf(s * (1.f / 1024.f) + EPS);
#pragma unroll
    for (int j = 0; j < 4; ++j) { const f32x4 y = v[j] * rstd * gs[j] + sh[j]; u32x2 w; w.x = cvtpk(y[0], y[1]); w.y = cvtpk(y[2], y[3]); *(u32x2*)(orow + 4 * lane + 256 * j) = w; }
}
__device__ __forceinline__ void norm_phase(const float* xlat, const float* xctx, const float* g, const float* modl, int sh_off, int sc_off, bf16_t* XN, bool do_ctx, int gw, int NGW, int lane_in, float* ctx_copy, const float* part, int nparts) {
    int lane = lane_in; asm volatile("" : "+v"(lane));
    for (int ch = gw; ch < 2048; ch += NGW) {
        const int v = ch < 1024 ? 0 : 1;
        f32x4 gs[4], sh[4];
#pragma unroll
        for (int j = 0; j < 4; ++j) { const int c = 4 * lane + 256 * j; gs[j] = *(const f32x4*)(g + c) * (*(const f32x4*)(modl + v * 6144 + sc_off + c) + 1.f); sh[j] = *(const f32x4*)(modl + v * 6144 + sh_off + c); }
        for (int i = 0; i < 8; ++i) { const int row = 8 * ch + i; norm_row(xlat + (size_t)row * DM, XN + (size_t)row * DM, gs, sh, lane, nullptr, nullptr, 0); }
    }
    if (do_ctx) {
        for (int rc = NGW - 1 - gw; rc < 2 * CTXL; rc += NGW) {
            f32x4 gs[4], sh[4];
#pragma unroll
            for (int j = 0; j < 4; ++j) { const int c = 4 * lane + 256 * j; gs[j] = *(const f32x4*)(g + c) * (*(const f32x4*)(modl + 2 * 6144 + sc_off + c) + 1.f); sh[j] = *(const f32x4*)(modl + 2 * 6144 + sh_off + c); }
            norm_row(xctx + (size_t)rc * DM, XN + (size_t)(NLAT + rc) * DM, gs, sh, lane, ctx_copy ? ctx_copy + (size_t)rc * DM : nullptr, part + (size_t)rc * DM, nparts);
        }
    }
}
constexpr int LDS_BYTES = 147456;

#ifndef REP_DIFF
#define REP_DIFF 1
#endif
#ifndef REP_NA
#define REP_NA 1
#endif
#ifndef REP_SYNC
#define REP_SYNC 1
#endif
#ifndef REP_PREP
#define REP_PREP 1
#endif
#ifndef REP_UP
#define REP_UP 1
#endif
#ifndef REP_WIN
#define REP_WIN 1
#endif
#ifndef REP_NORM
#define REP_NORM 1
#endif
#define GSYNC() do { for (int _r = 0; _r < REP_SYNC; ++_r) { XcdBarrier xb_ = xbar; { typedef __attribute__((address_space(1))) unsigned gu32_; gu32_* bp_ = (gu32_*)xb_.bar; asm volatile("" : "+s"(bp_)); xb_.bar = (unsigned*)bp_; } xcd_barrier(xb_, wave == 0 && lane_fresh() == 0); } } while (0)
#ifndef SPLITK
#define SPLITK 0
#endif
__global__ void __launch_bounds__(512, 2) hyb_fwd(Args a) {
    extern __shared__ __attribute__((aligned(16))) unsigned char lds_raw[];
    LAS unsigned char* lds = (LAS unsigned char*)lds_raw;
    cg::grid_group grid = cg::this_grid();
    const int wave = __builtin_amdgcn_readfirstlane((int)threadIdx.x >> 6);
#define LANE() lane_fresh()
#define TID() (wave * 64 + LANE())
    const int G = gridDim.x, bx = blockIdx.x;
    unsigned char* ws = a.ws;
    { volatile LAS unsigned* st0 = (volatile LAS unsigned*)(lds + LDS_BYTES - 128); if (wave == 0 && lane_fresh() < 2) st0[lane_fresh()] = 0u; }
    __syncthreads();
    const XcdBarrier xbar = xcd_barrier_post((unsigned*)(ws + WS_BAR), (volatile LAS unsigned*)(lds + LDS_BYTES - 128), wave == 0 && lane_fresh() == 0);
    const int gw = bx * 8 + wave, NGW = G * 8;

    prep_phase(a, lds, TID(), bx, G);
    for (int l = 0; l < 2; ++l) {
        { typedef __attribute__((address_space(1))) unsigned char gu8; gu8* wsg = (gu8*)ws; asm volatile("" : "+s"(wsg)); ws = (unsigned char*)wsg; }
        const float* modl = (const float*)(ws + WS_MOD) + l * 3 * 6144;
        bf16_t* XN = (bf16_t*)(ws + WS_XN) + DM;
        bf16_t* Pb = (bf16_t*)(ws + WS_P); bf16_t* Zt = (bf16_t*)(ws + WS_ZT); bf16_t* ZtC = (bf16_t*)(ws + WS_ZTC); bf16_t* A2t = (bf16_t*)(ws + WS_A2T);
        bf16_t* Yb = (bf16_t*)(ws + WS_Y); bf16_t* A2 = (bf16_t*)(ws + WS_A2); float* XC = (float*)(ws + WS_XC);
        unsigned char* wl = ws + WS_W + l * W_LAYER;
        const float* xin = l == 0 ? a.in[0] : a.out; const float* cin = l == 0 ? a.in[2] : XC;
        const bool ctxl = (l == 0);
        if (l == 0) {
            if (wave == 0 && lane_fresh() == 0) { unsigned sp = 0; while (xb_ld((unsigned*)(ws + WS_BAR) + 3648) < 192u && ++sp < (1u << 22)) __builtin_amdgcn_s_sleep(2);
                __builtin_amdgcn_fence(__ATOMIC_ACQUIRE, "agent"); asm volatile("s_waitcnt vmcnt(0)" ::: "memory"); }
            __syncthreads();
        }
        norm_phase(xin, cin, a.in[6] + l * DM, modl, 0, 1024, XN, true, gw, NGW, LANE(), XC, (const float*)(ws + WS_PART), (SPLITK && !ctxl) ? 11 : 0);
        GSYNC();
        {
            pg8::Gemm g{XN, (const bf16_t*)(wl + WO_IN), 1024, 0, (size_t)128 * 1024 * 2, (size_t)256 * 1024 * 2, 1024, 1024};
            pg8::TileOrder S; S.init(MT / 256, 9, G, bx);
            EpiWin E{Pb, Zt, ZtC, a.in[8] + l * 64, a.in[9] + l * 64, a.in[11] + l * 32, a.in[12] + l * 32, (const f32x2*)(ws + WS_ROPE)};
#ifndef NO_WIN
            for (int rep = 0; rep < REP_WIN; ++rep) {
                pg8::gemm_phase<EpiWin, pg8::TileOrder>(lds, g, S, E, wave);
                pg8::Gemm gz{XN, (const bf16_t*)(wl + WO_IN) + (size_t)2304 * 1024, 1024, 2, (size_t)256 * 1024 * 2, (size_t)0, 1024, 1024};
                pg8::TileOrder Sz; Sz.init(MT / 256, 2, G, (bx + G - 82) % G);
                EpiZ Ez{Zt, ZtC};
                pg8::gemm_phase<EpiZ, pg8::TileOrder>(lds, gz, Sz, Ez, wave);
            }
#endif
        }
        GSYNC();
        {
            unsigned* f1cnt = (unsigned*)(ws + WS_BAR) + 3520 + 64 * l;
#ifndef NO_NA
            for (int rep = 0; rep < REP_NA; ++rep)
            for (int u = bx; u < (ctxl ? 264 : 256); u += G) {
                if (u < 256) { const int xcd = u & 7, slot = u >> 3, b = slot >> 4, r = 16 * xcd + (slot & 15);
                    na_unit(lds, Pb, Yb, a.in[10] + l * 8 * 15 * 31, b * SEQ + 64 * r, b, r, wave, LANE()); }
                else { const int b = (u - 256) >> 2, qb = u & 3; na_unit(lds, Pb, Yb, a.in[10], NLAT + b * CTXL + 64 * qb, b, -1, wave, LANE()); }
            }
#endif
            __syncthreads();
            {
                pg8::Gemm g{(const bf16_t*)(ws + WS_M1), Zt, 256, 0, (size_t)128 * 256 * 2, (size_t)256 * 256 * 2, 256, 256};
                const int c1 = (bx + G / 2) % G;
                pg8::TileOrder S; S.init(1, 128, G, c1);
                EpiF1 E{A2t, (const f32x2*)(ws + WS_TW)};
#ifndef NO_F1
                pg8::gemm_phase<EpiF1, pg8::TileOrder>(lds, g, S, E, wave);
#endif
                if (c1 < 128) {
                    int n1 = 0; for (int L = c1; L < 128; L += G) ++n1;
                    if (wave == 0 && lane_fresh() == 0) { __builtin_amdgcn_fence(__ATOMIC_RELEASE, "agent"); asm volatile("s_waitcnt vmcnt(0)" ::: "memory"); xb_add(f1cnt, (unsigned)n1); }
                }
            }
            __syncthreads();
#ifndef NO_DIFF
            const float lam = ((const float*)(ws + WS_LAM))[2 * l], oms = ((const float*)(ws + WS_LAM))[2 * l + 1];
            for (int rep = 0; rep < REP_DIFF; ++rep)
            for (int u = bx; u < (ctxl ? 264 : 256); u += G) {
                int qrow0, b, h, t0;
                if (u < 256) { const int bh = u & 7, qb = u >> 3; b = bh >> 2; h = bh & 3; qrow0 = b * SEQ + 256 * qb; t0 = 0; }
                else { b = (u - 256) >> 2; h = u & 3; qrow0 = NLAT + b * CTXL; t0 = 128; }
                diff_unit(lds, Pb, Yb, a.in[14] + l * 64, qrow0, b, h, t0, 132, lam, oms, TID());
            }
#endif
            __syncthreads();
#ifndef NO_F2
            for (int pass = 0; pass < (ctxl ? 2 : 1); ++pass) {
                const int c2 = pass ? (bx + G - 72) % G : (bx + G - 8) % G;
                if (pass == 0 && c2 < 64) {
                    if (wave == 0 && lane_fresh() == 0) { unsigned sp = 0; while (xb_ld(f1cnt) < 128u && ++sp < (1u << 22)) __builtin_amdgcn_s_sleep(2);
                        __builtin_amdgcn_fence(__ATOMIC_ACQUIRE, "agent"); asm volatile("s_waitcnt vmcnt(0)" ::: "memory"); }
                    __syncthreads();
                }
                pg8::Gemm g{(const bf16_t*)(ws + (pass ? WS_MC : WS_M2)), pass ? ZtC : A2t, 512, 0, (size_t)128 * 512 * 2, (size_t)256 * 512 * 2, 512, 512};
                pg8::TileOrder S; S.init(1, pass ? 2 : 64, G, c2);
                EpiF2 E{Yb, pass};
                pg8::gemm_phase<EpiF2, pg8::TileOrder>(lds, g, S, E, wave);
            }
#endif
        }
        GSYNC();
        {
            for (int pass = 0; pass < ((ctxl && SPLITK) ? 2 : 1); ++pass) {
                pg8::Gemm g{Yb, (const bf16_t*)(wl + WO_OUT), pass ? 256 : 1024, 0, (size_t)128 * 1024 * 2, (size_t)256 * 1024 * 2, 1024, 1024};
                pg8::TileOrder S; S.init((ctxl && !SPLITK) ? 66 : 64, 4, G, bx, pass ? 4 : 0);
                EpiRes E{xin, a.out, XC, XC, modl + 2048, pass ? (float*)(ws + WS_PART) : nullptr};
                pg8::gemm_phase<EpiRes, pg8::TileOrder>(lds, g, S, E, wave);
            }
        }
        GSYNC();
#ifndef NO_NORM
        for (int rep = 0; rep < REP_NORM; ++rep) norm_phase(a.out, XC, a.in[17] + l * DM, modl, 3072, 4096, XN, ctxl, gw, NGW, LANE(), XC, (const float*)(ws + WS_PART), SPLITK ? 4 : 0);
#endif
        GSYNC();
        {
            const int Mrows = ctxl ? MT : NLAT;
            pg8::Gemm g{XN - DM, (const bf16_t*)(wl + WO_UP), 1024, 1, (size_t)4 * 1024 * 2, (size_t)252 * 1024 * 2, 1024, 1024};
            pg8::TileOrder S; S.init((Mrows + 251) / 252, 22, G, bx);
            EpiUp E{A2, a.in[19] + (size_t)l * 3 * 5632, a.in[20] + (size_t)l * 5632, Mrows};
#ifndef NO_UP
            for (int rep = 0; rep < REP_UP; ++rep) pg8::gemm_phase<EpiUp, pg8::TileOrder>(lds, g, S, E, wave);
#endif
        }
        GSYNC();
        {
            for (int pass = 0; pass < ((ctxl && SPLITK) ? 2 : 1); ++pass) {
                pg8::Gemm g{A2, (const bf16_t*)(wl + WO_DN), pass ? 256 : DFF, 0, (size_t)128 * DFF * 2, (size_t)256 * DFF * 2, DFF, DFF};
                pg8::TileOrder S; S.init((ctxl && !SPLITK) ? 66 : 64, 4, G, pass ? (bx + 128) % G : bx, pass ? 11 : 0);
                EpiRes E{a.out, a.out, XC, XC, modl + 5120, pass ? (float*)(ws + WS_PART) : nullptr};
                pg8::gemm_phase<EpiRes, pg8::TileOrder>(lds, g, S, E, wave);
            }
        }
        if (l == 0) GSYNC();
    }
}

extern "C" void kernel_launch(void* const* d_in, const int* in_sizes, int n_in, void* d_out, int out_size, void* d_ws, size_t ws_size, hipStream_t stream) {
    static int grid = 0;
    if (grid == 0) {
        if (n_in != 22 || out_size != NLAT * DM || ws_size < WS_END) { fprintf(stderr, "kernel_launch: unexpected shapes (n_in %d out %d ws %zu)\n", n_in, out_size, ws_size); grid = -1; return; }
        int dev = 0, cus = 0, per = 0;
        (void)hipGetDevice(&dev); (void)hipDeviceGetAttribute(&cus, hipDeviceAttributeMultiprocessorCount, dev);
        (void)hipFuncSetAttribute((const void*)hyb_fwd, hipFuncAttributeMaxDynamicSharedMemorySize, LDS_BYTES);
        (void)hipOccupancyMaxActiveBlocksPerMultiprocessor(&per, (const void*)hyb_fwd, 512, LDS_BYTES);
        (void)hipGetLastError();
        if (per < 1) fprintf(stderr, "kernel_launch: occupancy query says %d blocks/CU\n", per);
        grid = cus;
    }
    if (grid < 0) return;
    (void)hipMemsetAsync((unsigned char*)d_ws + WS_BAR, 0, 16384, stream);
    Args a{};
    for (int i = 0; i < 22; ++i) a.in[i] = (const float*)d_in[i];
    a.out = (float*)d_out; a.ws = (unsigned char*)d_ws;
    void* args[] = {&a};
    hipError_t e = hipLaunchCooperativeKernel((const void*)hyb_fwd, dim3(grid), dim3(512), args, LDS_BYTES, stream);
    if (e != hipSuccess) fprintf(stderr, "kernel_launch: cooperative launch failed: %s (grid %d)\n", hipGetErrorString(e), grid);
}
```

```cpp
#include <hip/hip_runtime.h>
#include <hip/hip_cooperative_groups.h>
#include <cstdio>
#include <cstdint>
namespace cg = cooperative_groups;

#define LAS __attribute__((address_space(3)))
typedef unsigned short bf16_t;
typedef short bf16x8 __attribute__((ext_vector_type(8)));
typedef short s16x4 __attribute__((ext_vector_type(4)));
typedef float f32x4 __attribute__((ext_vector_type(4)));
typedef float f32x2 __attribute__((ext_vector_type(2)));
typedef float f32x16 __attribute__((ext_vector_type(16)));
typedef unsigned u32x4 __attribute__((ext_vector_type(4)));
typedef unsigned u32x2 __attribute__((ext_vector_type(2)));
typedef __bf16 bf16x2_t __attribute__((ext_vector_type(2)));

constexpr int SEQ = 8192, DM = 1024, CTXL = 256, NLAT = 2 * SEQ, MT = NLAT + 2 * CTXL;
constexpr int PP = 2304;
constexpr int NAQ0 = 0, NAK0 = 512, NAV0 = 1024, DQ0 = 1536, DK0 = 1792, DV0 = 2048, FN0 = 2304, INW = 2560;
constexpr int NIN = 2816;
constexpr int DFF = 2816;
constexpr float EPS = 1e-6f, LOG2E = 1.4426950408889634f;

__device__ __forceinline__ unsigned cvtpk(float lo, float hi) { f32x2 v = {lo, hi}; bf16x2_t b = __builtin_convertvector(v, bf16x2_t); return __builtin_bit_cast(unsigned, b); }
__device__ __forceinline__ int lane_fresh() { int l; asm volatile("v_mbcnt_lo_u32_b32 %0, -1, 0\n\tv_mbcnt_hi_u32_b32 %0, -1, %0" : "=v"(l)); return l; }
__device__ __forceinline__ int lane_fresh();
__device__ __forceinline__ float bperm_xor(float v, int m) { int l; asm volatile("v_mbcnt_lo_u32_b32 %0, -1, 0\n\tv_mbcnt_hi_u32_b32 %0, -1, %0" : "=v"(l)); return __builtin_bit_cast(float, __builtin_amdgcn_ds_bpermute((l ^ m) << 2, __builtin_bit_cast(int, v))); }
#define SWZ_XOR(v, m) bperm_xor((v), (m))
__device__ __forceinline__ float sum_xor32(float v) { return v + bperm_xor(v, 32); }
__device__ __forceinline__ bf16_t f2bf(float f) { return (bf16_t)(cvtpk(f, 0.f) & 0xffffu); }

namespace pg8 {
constexpr int BM = 256, BK = 64, HALF = 128, HTB = HALF * BK * 2, STAGE_BYTES = 8 * HTB, NXCD = 8, WGM = 8;
__host__ __device__ __forceinline__ int lds_byte(int r, int c) { const int st = (r >> 4) * 2 + (c >> 5), rr = r & 15, cc = c & 31, ob = rr * 64 + cc * 2; return st * 1024 + (ob ^ (((ob >> 9) & 1) << 5)); }
__host__ __device__ __forceinline__ void stage_rc(int b, int& R, int& C) { const int st = b / 1024, sb = b % 1024, swz = sb ^ (((sb >> 9) & 1) << 5); R = (st >> 1) * 16 + swz / 64; C = (st & 1) * 32 + (swz % 64) / 2; }
__host__ __device__ __forceinline__ int perm32(int rho) { const int n = rho >> 4, i = rho & 15; return 8 * (i >> 2) + 4 * n + (i & 3); }

struct Unit { int pm, pn, kc; };
struct Gemm { const bf16_t* A; const bf16_t* Bt; int K; int amode; size_t a_half, a_tile; int lda, ldb; };

struct TileOrder {
    int nM, nN, nwg, G, c, nk;
    __device__ void init(int nM_, int nN_, int G_, int c_, int nk_ = 0) { nM = nM_; nN = nN_; nwg = nM * nN; G = G_; c = c_; nk = nk_; }
    __device__ bool next(int i, Unit& u) const {
        if (nk > 0) { const int L2 = i * G + c; if (L2 >= 8 * nk) return false; u.pm = 64 + (L2 & 1); u.pn = (L2 >> 1) & 3; u.kc = L2 >> 3; return true; }
        const long L = (long)i * G + c; if (L >= nwg) return false;
        int wgid = (int)L; { const int q = nwg / NXCD, r = nwg % NXCD, xcd = wgid % NXCD, off = wgid / NXCD; wgid = (xcd < r ? xcd * (q + 1) : r * (q + 1) + (xcd - r) * q) + off; }
        const int nig = WGM * nN, gid = wgid / nig, fm = gid * WGM, gsz = (nM - fm) < WGM ? (nM - fm) : WGM;
        u.pm = fm + ((wgid % nig) % gsz); u.pn = (wgid % nig) / gsz; u.kc = 0; return true;
    }
};

template <class Epi, class Sched, bool ALIGN_EPI = true>
__device__ __forceinline__ void gemm_phase(LAS unsigned char* lds, const Gemm g, const Sched& S, const Epi& E, int wid) {
    const int lane = lane_fresh(), tid = wid * 64 + lane, wr = wid >> 2, wc = wid & 3, fr = lane & 15, fq = lane >> 4;
    const int K = g.K, nt = K / BK;
    unsigned voffA[2], voffB[2];
#pragma unroll
    for (int i = 0; i < 2; ++i) { int R, C; stage_rc(tid * 16 + i * 8192, R, C); const int Rb = Epi::PERM ? ((R & ~31) + perm32(R & 31)) : R;
        const int Ra = g.amode == 1 ? (126 * (R >> 6) + 8 * (R & 15) + ((R >> 4) & 3)) : (g.amode == 2 ? (64 * ((R >> 4) & 3) + 16 * (R >> 6) + (R & 15)) : R);
        voffA[i] = (unsigned)(Ra * g.lda + C) * 2u; voffB[i] = (unsigned)(Rb * g.ldb + C) * 2u; }
    const size_t kstep = (size_t)(BK * 2);
    const size_t hstepB = (size_t)HALF * g.ldb * 2, tstepB = 2 * hstepB, kchunk = (size_t)K * 2;
    const size_t hstepA = g.a_half, tstepA = g.a_tile;
    const unsigned ldsw = (unsigned)wid * 1024u;
    const int aoff = lds_byte(wr * 64 + fr, fq * 8), boff = lds_byte(wc * 32 + fr, fq * 8);
#define PG8_SA(b, h) (((b) * 2 + (h)) * HTB)
#define PG8_SB(b, h) ((4 + (b) * 2 + (h)) * HTB)
#define PG8_STAGE(bufoff, gbase, voff) do { _Pragma("unroll") for (int _i = 0; _i < 2; ++_i) \
        __builtin_amdgcn_global_load_lds((const unsigned*)((const char*)(gbase) + (voff)[_i]), (LAS unsigned*)(lds + (bufoff) + ldsw + _i * 8192), 16, 0, 0); } while (0)
#define PG8_LDA(dst, b, h) do { _Pragma("unroll") for (int m = 0; m < 4; ++m) _Pragma("unroll") for (int k = 0; k < 2; ++k) dst[m][k] = *(const LAS bf16x8*)(lds + PG8_SA(b, h) + aoff + m * 2048 + k * 1024); } while (0)
#define PG8_LDB(dst, b, h) do { _Pragma("unroll") for (int n = 0; n < 2; ++n) _Pragma("unroll") for (int k = 0; k < 2; ++k) dst[n][k] = *(const LAS bf16x8*)(lds + PG8_SB(b, h) + boff + n * 2048 + k * 1024); } while (0)
#define PG8_MMA(ai, bj, At, Bt) do { __builtin_amdgcn_s_setprio(1); _Pragma("unroll") for (int m = 0; m < 4; ++m) _Pragma("unroll") for (int n = 0; n < 2; ++n) _Pragma("unroll") for (int k = 0; k < 2; ++k) \
        acc[ai][bj][m][n] = __builtin_amdgcn_mfma_f32_16x16x32_bf16(Bt[n][k], At[m][k], acc[ai][bj][m][n], 0, 0, 0); __builtin_amdgcn_s_setprio(0); } while (0)
#define PG8_WAIT_V(n) asm volatile("s_waitcnt vmcnt(" #n ")" ::: "memory")
#define PG8_WAIT_L(n) asm volatile("s_waitcnt lgkmcnt(" #n ")" ::: "memory")
#define PG8_BAR __builtin_amdgcn_s_barrier()
#define PG8_SCHED __builtin_amdgcn_sched_barrier(0)
    Unit cur, nxt; int ui = 0;
    if (!S.next(0, cur)) return;
    f32x4 acc[2][2][4][2];
#pragma unroll
    for (int a = 0; a < 2; ++a)
#pragma unroll
        for (int b = 0; b < 2; ++b)
#pragma unroll
            for (int m = 0; m < 4; ++m)
#pragma unroll
                for (int n = 0; n < 2; ++n) acc[a][b][m][n] = (f32x4){0.f, 0.f, 0.f, 0.f};
    bf16x8 At[4][2], B0[2][2], B1[2][2];
#define PG8_ABASE(pm_) (g.amode == 2 ? (size_t)(((pm_) >> 1) * 512 + ((pm_) & 1) * 32) * g.lda * 2 : (size_t)(pm_) * tstepA)
    const char* cA = (const char*)g.A + PG8_ABASE(cur.pm) + (size_t)cur.kc * kchunk; const char* cB = (const char*)g.Bt + (size_t)cur.pn * tstepB + (size_t)cur.kc * kchunk;
    {
        PG8_STAGE(PG8_SB(0, 0), cB, voffB); PG8_STAGE(PG8_SB(0, 1), cB + hstepB, voffB); PG8_STAGE(PG8_SA(0, 0), cA, voffA); PG8_STAGE(PG8_SA(0, 1), cA + hstepA, voffA);
        if (wr == 1) PG8_BAR;
        PG8_WAIT_V(2); PG8_BAR;
        PG8_STAGE(PG8_SB(1, 0), cB + kstep, voffB); PG8_STAGE(PG8_SA(1, 0), cA + kstep, voffA); PG8_STAGE(PG8_SB(1, 1), cB + hstepB + kstep, voffB);
        PG8_WAIT_V(6); PG8_BAR;
    }
    for (;;) {
        const bool has_next = S.next(ui + 1, nxt);
        const char* nA = has_next ? (const char*)g.A + PG8_ABASE(nxt.pm) + (size_t)nxt.kc * kchunk : cA; const char* nB = has_next ? (const char*)g.Bt + (size_t)nxt.pn * tstepB + (size_t)nxt.kc * kchunk : cB;
        for (int t = 0; t < nt; t += 2) {
            const bool last = (t == nt - 2);
            const char* a1 = cA + (size_t)(t + 1) * kstep;
            const char* a2 = last ? nA : cA + (size_t)(t + 2) * kstep; const char* b2 = last ? nB : cB + (size_t)(t + 2) * kstep;
            const char* a3 = a2 + kstep; const char* b3 = b2 + kstep;
            PG8_LDB(B0, 0, 0); PG8_LDB(B1, 0, 1); PG8_SCHED; PG8_LDA(At, 0, 0); PG8_STAGE(PG8_SA(1, 1), a1 + hstepA, voffA);
            PG8_WAIT_V(8); PG8_WAIT_L(0); PG8_BAR; PG8_MMA(0, 0, At, B0); PG8_MMA(0, 1, At, B1); PG8_BAR; PG8_SCHED;
            PG8_LDA(At, 0, 1); PG8_STAGE(PG8_SB(0, 0), b2, voffB); PG8_STAGE(PG8_SB(0, 1), b2 + hstepB, voffB); PG8_STAGE(PG8_SA(0, 0), a2, voffA);
            PG8_WAIT_V(8); PG8_WAIT_L(0); PG8_BAR; PG8_MMA(1, 0, At, B0); PG8_MMA(1, 1, At, B1); PG8_BAR; PG8_SCHED;
            PG8_LDB(B0, 1, 0); PG8_LDB(B1, 1, 1); PG8_SCHED; PG8_LDA(At, 1, 0); PG8_STAGE(PG8_SA(0, 1), a2 + hstepA, voffA);
            PG8_WAIT_V(8); PG8_WAIT_L(0); PG8_BAR; PG8_MMA(0, 0, At, B0); PG8_MMA(0, 1, At, B1); PG8_BAR; PG8_SCHED;
            PG8_LDA(At, 1, 1); PG8_STAGE(PG8_SB(1, 0), b3, voffB); PG8_STAGE(PG8_SB(1, 1), b3 + hstepB, voffB); PG8_STAGE(PG8_SA(1, 0), a3, voffA);
            PG8_WAIT_V(8); PG8_WAIT_L(0); PG8_BAR; PG8_MMA(1, 0, At, B0); PG8_MMA(1, 1, At, B1); PG8_BAR; PG8_SCHED;
        }
        if constexpr (ALIGN_EPI) { if (wr == 0) PG8_BAR; }
        { const int ln = lane_fresh(); E(acc, cur, wr, wc, ln & 15, ln >> 4); }
        if (!has_next) break;
#pragma unroll
        for (int a = 0; a < 2; ++a)
#pragma unroll
            for (int b = 0; b < 2; ++b)
#pragma unroll
                for (int m = 0; m < 4; ++m)
#pragma unroll
                    for (int n = 0; n < 2; ++n) acc[a][b][m][n] = (f32x4){0.f, 0.f, 0.f, 0.f};
        cur = nxt; cA = nA; cB = nB; ++ui;
        if constexpr (ALIGN_EPI) { if (wr == 1) PG8_BAR; }
    }
    PG8_WAIT_V(0);
    if constexpr (!ALIGN_EPI) { if (wr == 0) PG8_BAR; }
    PG8_BAR;
#undef PG8_ABASE
#undef PG8_SA
#undef PG8_SB
#undef PG8_STAGE
#undef PG8_LDA
#undef PG8_LDB
#undef PG8_MMA
#undef PG8_WAIT_V
#undef PG8_WAIT_L
#undef PG8_BAR
#undef PG8_SCHED
}
}
#define RLX_AGENT __ATOMIC_RELAXED, __HIP_MEMORY_SCOPE_AGENT
#define XB_TMO      128
#define XB_XCNT(j)  (256  + 64 * (j))
#define XB_XSUB(j)  (1280 + 64 * (j))
#define XB_XGEN(j)  (2304 + 64 * (j))
#define XB_TOP      3328
#define XB_TOPGEN   3392
#define XCD_BAR_WORDS 3456
#define XB_SPIN_CAP (1u << 18)

__device__ __forceinline__ unsigned xb_ld(unsigned* p)              { return __hip_atomic_load(p, __ATOMIC_RELAXED, __HIP_MEMORY_SCOPE_AGENT); }
__device__ __forceinline__ unsigned xb_add(unsigned* p, unsigned v) { return __hip_atomic_fetch_add(p, v, __ATOMIC_RELAXED, __HIP_MEMORY_SCOPE_AGENT); }
__device__ __forceinline__ unsigned xb_xcc_id() { return (unsigned)__builtin_amdgcn_s_getreg((3 << 11) | 20) & 0xFu; }
#define XB_SPIN(cond, bar) do { unsigned _sp = 0; while (cond) { __builtin_amdgcn_s_sleep(1); \
    if ((++_sp & 255u) == 0u) { if (xb_ld(&(bar)[XB_TMO])) break; if (_sp > XB_SPIN_CAP) { atomicAdd(&(bar)[XB_TMO], 1u); break; } } } } while (0)

struct XcdBarrier {
    unsigned* bar; unsigned x;
    volatile LAS unsigned* st;
};

__device__ __forceinline__ XcdBarrier xcd_barrier_post(unsigned* bar, volatile LAS unsigned* st, bool t0) {
    XcdBarrier b; b.bar = bar; b.x = xb_xcc_id(); b.st = st;
    if (t0) (void)xb_add(&bar[XB_XCNT(b.x)], 1u);
    return b;
}
__device__ __forceinline__ void xcd_barrier_complete(unsigned* bar, unsigned x, unsigned& nloc, unsigned& nx) {
    const unsigned G = gridDim.x * gridDim.y * gridDim.z;
    unsigned sum, cnt, mine, sp = 0u;
    for (;;) {
        sum = 0u; cnt = 0u; mine = 0u;
#pragma unroll
        for (unsigned j = 0; j < 16; ++j) { const unsigned c = xb_ld(&bar[XB_XCNT(j)]); sum += c; cnt += (c > 0u) ? 1u : 0u; mine = (j == x) ? c : mine; }
        if (sum == G) break;
        __builtin_amdgcn_s_sleep(1);
        if ((++sp & 255u) == 0u) { if (xb_ld(&bar[XB_TMO])) break; if (sp > XB_SPIN_CAP) { atomicAdd(&bar[XB_TMO], 1u); break; } }
    }
    nloc = mine > 0u ? mine : 1u; nx = cnt > 0u ? cnt : 1u;
}

__device__ __forceinline__ void xcd_barrier(const XcdBarrier& b, bool t0) {
    asm volatile("s_waitcnt vmcnt(0)" ::: "memory");
    __syncthreads();
    if (t0) {
        unsigned* bar = b.bar;
        __builtin_amdgcn_s_waitcnt(0);
        unsigned nloc = b.st[0], nx = b.st[1];
        if (nloc == 0u) { xcd_barrier_complete(bar, b.x, nloc, nx); b.st[0] = nloc; b.st[1] = nx; }
        const unsigned old = xb_add(&bar[XB_XSUB(b.x)], 1u);
        const unsigned gen = old / nloc;
        if (old + 1u == (gen + 1u) * nloc) {
            __builtin_amdgcn_fence(__ATOMIC_RELEASE, "agent");
            asm volatile("s_waitcnt vmcnt(0)" ::: "memory");
            const unsigned og = xb_add(&bar[XB_TOP], 1u);
            const unsigned tg = og / nx;
            if (og + 1u == (tg + 1u) * nx) xb_add(&bar[XB_TOPGEN], 1u);
            else XB_SPIN(xb_ld(&bar[XB_TOPGEN]) == tg, bar);
            __builtin_amdgcn_fence(__ATOMIC_ACQUIRE, "agent");
            xb_add(&bar[XB_XGEN(b.x)], 1u);
            asm volatile("s_waitcnt vmcnt(0)" ::: "memory");
        } else {
            XB_SPIN(xb_ld(&bar[XB_XGEN(b.x)]) == gen, bar);
            __builtin_amdgcn_fence(__ATOMIC_ACQUIRE, "agent");
            asm volatile("s_waitcnt vmcnt(0)" ::: "memory");
        }
    }
    __syncthreads();
}

using pg8::Unit;
__device__ __forceinline__ int dimperm(int i) { const int fq = i >> 3, n = (i >> 2) & 1, j = i & 3, pi = 4 * fq + j; return (pi < 8 ? pi : 8 + pi) + 8 * n; }

struct EpiWin {
    static constexpr bool PERM = true;
    bf16_t* P; bf16_t* Zt; bf16_t* ZtC; const float* nqg; const float* nkg; const float* dqg; const float* dkg; const f32x2* rope;
    __device__ __forceinline__ void operator()(const f32x4 (&acc)[2][2][4][2], const Unit& u, int wr, int wc, int fr_, int fq_) const {
        int fr = fr_, fq = fq_; asm volatile("" : "+v"(fr), "+v"(fq));
        const int pn = u.pn, row0 = u.pm * 256 + wr * 64 + fr;
        if (pn >= 9) {
            const int gma = 128 * (pn - 9) + 16 * wc + 4 * fq;
#pragma unroll
            for (int ai = 0; ai < 2; ++ai)
#pragma unroll
                for (int m = 0; m < 4; ++m) {
                    const int row = row0 + 128 * ai + 16 * m;
#pragma unroll
                    for (int bj = 0; bj < 2; ++bj)
#pragma unroll
                        for (int n = 0; n < 2; ++n) {
                            const f32x4 v = acc[ai][bj][m][n]; const unsigned w0 = cvtpk(v[0], v[1]), w1 = cvtpk(v[2], v[3]);
                            const int gm = gma + 64 * bj + 2 * n;
                            if (row < NLAT) {
                                const int b = row >> 13, nn = row & 8191, n1 = nn >> 6, n2 = nn & 63;
                                const size_t r0 = ((((size_t)(b * 16 + (gm >> 4)) * 4 + (n2 >> 4)) * 16 + (gm & 15)) * 16 + (n2 & 15));
                                *(unsigned*)(Zt + r0 * 256 + 2 * n1) = w0;
                                *(unsigned*)(Zt + (r0 + 16) * 256 + 2 * n1) = w1;
                            } else {
                                const int rc = row - NLAT, b = rc >> 8, nn = rc & 255;
                                *(unsigned*)(ZtC + ((size_t)(b * 256 + gm)) * 512 + 2 * nn) = w0;
                                *(unsigned*)(ZtC + ((size_t)(b * 256 + gm + 1)) * 512 + 2 * nn) = w1;
                            }
                        }
                }
            return;
        }
        const int colb = 256 * pn + 64 * wc + 8 * fq;
        if (pn == 4 || pn == 5 || pn == 8) {
#pragma unroll
            for (int ai = 0; ai < 2; ++ai)
#pragma unroll
                for (int m = 0; m < 4; ++m) { bf16_t* rowp = P + (size_t)(row0 + 128 * ai + 16 * m) * PP + colb;
#pragma unroll
                    for (int bj = 0; bj < 2; ++bj) { const f32x4 v0 = acc[ai][bj][m][0], v1 = acc[ai][bj][m][1]; u32x4 w; w.x = cvtpk(v0[0], v0[1]); w.y = cvtpk(v0[2], v0[3]); w.z = cvtpk(v1[0], v1[1]); w.w = cvtpk(v1[2], v1[3]);
                        *(u32x4*)(rowp + 32 * bj) = w; } }
            return;
        }
        if (pn < 4) {
            const bool isq = pn < 2; const float* gp = (isq ? nqg : nkg) + 8 * fq;
            const float osc = isq ? 0.125f * LOG2E : 1.0f;
            f32x4 gv[2][2];
#pragma unroll
            for (int bj = 0; bj < 2; ++bj)
#pragma unroll
                for (int n = 0; n < 2; ++n) gv[bj][n] = *(const f32x4*)(gp + 32 * bj + 4 * n) * osc;
#pragma unroll
            for (int ai = 0; ai < 2; ++ai)
#pragma unroll
                for (int m = 0; m < 4; ++m) {
                    float ss = 0.f;
#pragma unroll
                    for (int bj = 0; bj < 2; ++bj)
#pragma unroll
                        for (int n = 0; n < 2; ++n) { const f32x4 v = acc[ai][bj][m][n]; ss += (v[0] * v[0] + v[1] * v[1]) + (v[2] * v[2] + v[3] * v[3]); }
                    ss += SWZ_XOR(ss, 16); ss = sum_xor32(ss);
                    const float rstd = __builtin_amdgcn_rsqf(ss * (1.f / 64.f) + EPS);
                    bf16_t* rowp = P + (size_t)(row0 + 128 * ai + 16 * m) * PP + colb;
#pragma unroll
                    for (int bj = 0; bj < 2; ++bj) { const f32x4 v0 = acc[ai][bj][m][0] * rstd * gv[bj][0], v1 = acc[ai][bj][m][1] * rstd * gv[bj][1];
                        u32x4 w; w.x = cvtpk(v0[0], v0[1]); w.y = cvtpk(v0[2], v0[3]); w.z = cvtpk(v1[0], v1[1]); w.w = cvtpk(v1[2], v1[3]);
                        *(u32x4*)(rowp + 32 * bj) = w; }
                }
            return;
        }
        {
            const bool isq = pn == 6; const float* gp = isq ? dqg : dkg;
            const float osc = isq ? 0.17677669529663687f * LOG2E : 1.0f;
            const bool lat = u.pm < 64;
            f32x4 gv[2];
#pragma unroll
            for (int n = 0; n < 2; ++n)
#pragma unroll
                for (int j = 0; j < 4; ++j) gv[n][j] = gp[dimperm(8 * fq + 4 * n + j)];
#pragma unroll
            for (int ai = 0; ai < 2; ++ai)
#pragma unroll
                for (int m = 0; m < 4; ++m) {
                    const int row = row0 + 128 * ai + 16 * m;
                    f32x2 cs[4];
                    if (lat) { const int gr = (row >> 6) & 127, gc = row & 63; const int pos = (fq < 2) ? gr : gc;
#pragma unroll
                        for (int j = 0; j < 4; ++j) cs[j] = rope[pos * 8 + ((4 * fq + j) & 7)]; }
                    else {
#pragma unroll
                        for (int j = 0; j < 4; ++j) cs[j] = (f32x2){1.f, 0.f}; }
                    bf16_t* rowp = P + (size_t)row * PP + colb;
#pragma unroll
                    for (int bj = 0; bj < 2; ++bj) {
                        const f32x4 a0 = acc[ai][bj][m][0], a1 = acc[ai][bj][m][1];
                        float ss = (a0[0] * a0[0] + a0[1] * a0[1]) + (a0[2] * a0[2] + a0[3] * a0[3]) + (a1[0] * a1[0] + a1[1] * a1[1]) + (a1[2] * a1[2] + a1[3] * a1[3]);
                        ss += SWZ_XOR(ss, 16); ss = sum_xor32(ss);
                        const float rstd = __builtin_amdgcn_rsqf(ss * (1.f / 32.f) + EPS);
                        const f32x4 x1 = a0 * rstd * gv[0], x2 = a1 * rstd * gv[1];
                        f32x4 y1, y2;
#pragma unroll
                        for (int j = 0; j < 4; ++j) { y1[j] = (x1[j] * cs[j].x - x2[j] * cs[j].y) * osc; y2[j] = (x1[j] * cs[j].y + x2[j] * cs[j].x) * osc; }
                        u32x4 w; w.x = cvtpk(y1[0], y1[1]); w.y = cvtpk(y1[2], y1[3]); w.z = cvtpk(y2[0], y2[1]); w.w = cvtpk(y2[2], y2[3]);
                        *(u32x4*)(rowp + 32 * bj) = w;
                    }
                }
        }
    }
};

struct EpiZ {
    static constexpr bool PERM = true;
    bf16_t* Zt; bf16_t* ZtC;
    __device__ __forceinline__ void operator()(const f32x4 (&acc)[2][2][4][2], const Unit& u, int wr, int wc, int fr_, int fq_) const {
        int fr = fr_, fq = fq_; asm volatile("" : "+v"(fr), "+v"(fq));
        const int gma = 128 * u.pn + 16 * wc + 4 * fq;
        if (u.pm < 64) {
            const int b = u.pm >> 5, tp = u.pm & 31, n1b = 8 * (tp >> 1), n2 = 32 * (tp & 1) + 16 * wr + fr;
#pragma unroll
            for (int bj = 0; bj < 2; ++bj)
#pragma unroll
                for (int n = 0; n < 2; ++n)
#pragma unroll
                    for (int p = 0; p < 2; ++p) {
                        const int gm = gma + 64 * bj + 2 * n + p;
                        const size_t r0 = ((((size_t)(b * 16 + (gm >> 4)) * 4 + (n2 >> 4)) * 16 + (gm & 15)) * 16 + (n2 & 15));
#pragma unroll
                        for (int ai = 0; ai < 2; ++ai) { u32x4 w;
#pragma unroll
                            for (int m = 0; m < 4; ++m) w[m] = cvtpk(acc[ai][bj][m][n][2 * p], acc[ai][bj][m][n][2 * p + 1]);
                            *(u32x4*)(Zt + r0 * 256 + 2 * (n1b + 4 * ai)) = w; }
                    }
        } else {
#pragma unroll
            for (int ai = 0; ai < 2; ++ai)
#pragma unroll
                for (int m = 0; m < 4; ++m) {
                    const int idx = 32 * (u.pm & 1) + 64 * (4 * ai + m) + 16 * wr + fr, b = idx >> 8, nn = idx & 255;
#pragma unroll
                    for (int bj = 0; bj < 2; ++bj)
#pragma unroll
                        for (int n = 0; n < 2; ++n)
#pragma unroll
                            for (int p = 0; p < 2; ++p) { const int gm = gma + 64 * bj + 2 * n + p;
                                *(unsigned*)(ZtC + ((size_t)(b * 256 + gm)) * 512 + 2 * nn) = cvtpk(acc[ai][bj][m][n][2 * p], acc[ai][bj][m][n][2 * p + 1]); }
                }
        }
    }
};

struct EpiRes {
    static constexpr bool PERM = false;
    const float* base_lat; float* out_lat; const float* base_ctx; float* out_ctx; const float* gate; float* part;
    __device__ __forceinline__ void operator()(const f32x4 (&acc)[2][2][4][2], const Unit& u, int wr, int wc, int fr_, int fq_) const {
        int fr = fr_, fq = fq_; asm volatile("" : "+v"(fr), "+v"(fq));
        const int v = u.pm < 32 ? 0 : (u.pm < 64 ? 1 : 2);
        const float* bp; float* op; int row0;
        if (u.pm < 64) { bp = base_lat; op = out_lat; row0 = u.pm * 256 + wr * 64 + fr; } else { bp = base_ctx; op = out_ctx; row0 = (u.pm - 64) * 256 + wr * 64 + fr; }
        const int col0 = u.pn * 256 + wc * 32 + 4 * fq;
        f32x4 gv[2][2];
#pragma unroll
        for (int bj = 0; bj < 2; ++bj)
#pragma unroll
            for (int n = 0; n < 2; ++n) gv[bj][n] = *(const f32x4*)(gate + v * 6144 + col0 + 128 * bj + 16 * n);
#pragma unroll
        for (int ai = 0; ai < 2; ++ai)
#pragma unroll
            for (int m = 0; m < 4; ++m) { const size_t off = (size_t)(row0 + 128 * ai + 16 * m) * DM + col0;
#pragma unroll
                for (int bj = 0; bj < 2; ++bj)
#pragma unroll
                    for (int n = 0; n < 2; ++n) {
                        if (part) { *(f32x4*)(part + (size_t)u.kc * (512 * DM) + off + 128 * bj + 16 * n) = gv[bj][n] * acc[ai][bj][m][n]; }
                        else { const f32x4 bs = *(const f32x4*)(bp + off + 128 * bj + 16 * n); *(f32x4*)(op + off + 128 * bj + 16 * n) = bs + gv[bj][n] * acc[ai][bj][m][n]; } }
                if (m & 1) asm volatile("" ::: "memory"); }
    }
};

__device__ __forceinline__ float dpp_shr1(float v) { return __builtin_bit_cast(float, __builtin_amdgcn_update_dpp(0, __builtin_bit_cast(int, v), 0x111, 0xf, 0xf, true)); }
__device__ __forceinline__ float dpp_shl1(float v) { return __builtin_bit_cast(float, __builtin_amdgcn_update_dpp(0, __builtin_bit_cast(int, v), 0x101, 0xf, 0xf, true)); }

struct EpiUp {
    static constexpr bool PERM = true;
    bf16_t* A2; const float* cw; const float* cb; int Mrows;
    __device__ __forceinline__ void operator()(const f32x4 (&acc)[2][2][4][2], const Unit& u, int wr, int wc, int fr_, int fq_) const {
        int fr = fr_, fq = fq_; asm volatile("" : "+v"(fr), "+v"(fq));
        const int T0 = 252 * u.pm, tokb = T0 - 1 + 126 * wr + 8 * fr;
        const int jg0 = 128 * u.pn + 32 * wc + 8 * fq;
        const int lo = T0 + 126 * wr, hiT = (lo + 126 < Mrows) ? lo + 126 : Mrows;
#pragma unroll
        for (int n = 0; n < 2; ++n) {
            const int jc = jg0 + 4 * n;
            const f32x4 g0 = *(const f32x4*)(cw + jc), g1 = *(const f32x4*)(cw + 2 * DFF + jc), g2 = *(const f32x4*)(cw + 4 * DFF + jc), gb = *(const f32x4*)(cb + jc);
            const f32x4 v0 = *(const f32x4*)(cw + DFF + jc), v1 = *(const f32x4*)(cw + 3 * DFF + jc), v2 = *(const f32x4*)(cw + 5 * DFF + jc), vb = *(const f32x4*)(cb + DFF + jc);
            f32x4 gprev, gnext, vprev, vnext;
#pragma unroll
            for (int j = 0; j < 4; ++j) { gprev[j] = dpp_shr1(acc[1][0][3][n][j]); gnext[j] = dpp_shl1(acc[0][0][0][n][j]); vprev[j] = dpp_shr1(acc[1][1][3][n][j]); vnext[j] = dpp_shl1(acc[0][1][0][n][j]); }
#pragma unroll
            for (int i8 = 0; i8 < 8; ++i8) {
                const int tok = tokb + i8; const int msk = tok < NLAT ? 8191 : 255;
                const bool first = (tok & msk) == 0, lastt = ((tok + 1) & msk) == 0;
                const f32x4 gc = acc[i8 >> 2][0][i8 & 3][n], vc = acc[i8 >> 2][1][i8 & 3][n];
                f32x4 gp = i8 > 0 ? acc[(i8 - 1) >> 2][0][(i8 - 1) & 3][n] : gprev, gn = i8 < 7 ? acc[(i8 + 1) >> 2][0][(i8 + 1) & 3][n] : gnext;
                f32x4 vp = i8 > 0 ? acc[(i8 - 1) >> 2][1][(i8 - 1) & 3][n] : vprev, vn = i8 < 7 ? acc[(i8 + 1) >> 2][1][(i8 + 1) & 3][n] : vnext;
                if (first) { gp = (f32x4){0.f, 0.f, 0.f, 0.f}; vp = gp; }
                if (lastt) { gn = (f32x4){0.f, 0.f, 0.f, 0.f}; vn = gn; }
                const f32x4 cg = g0 * gp + g1 * gc + g2 * gn + gb, cv = v0 * vp + v1 * vc + v2 * vn + vb;
                f32x4 r;
#pragma unroll
                for (int j = 0; j < 4; ++j) r[j] = cg[j] * __builtin_amdgcn_rcpf(1.f + __builtin_amdgcn_exp2f(-LOG2E * cg[j])) * cv[j];
                if (tok >= lo && tok < hiT) { u32x2 w; w.x = cvtpk(r[0], r[1]); w.y = cvtpk(r[2], r[3]); *(u32x2*)(A2 + (size_t)tok * DFF + jc) = w; }
            }
        }
    }
};

struct EpiF1 {
    static constexpr bool PERM = true;
    bf16_t* A2t; const f32x2* tw;
    __device__ __forceinline__ void operator()(const f32x4 (&acc)[2][2][4][2], const Unit& u, int wr, int wc, int fr_, int fq_) const {
        int fr = fr_, fq = fq_; asm volatile("" : "+v"(fr), "+v"(fq));
        const int pn = u.pn, n2hi = pn & 3, gmhi = (pn >> 2) & 15, b = pn >> 6;
        const int n2b = 16 * n2hi + 8 * (fq & 1);
#pragma unroll
        for (int m = 0; m < 4; ++m) {
            const int k1 = 64 * wr + 16 * m + fr, k1grp = k1 >> 2, k1lo = k1 & 3;
#pragma unroll
            for (int n = 0; n < 2; ++n) {
                f32x2 t[4];
#pragma unroll
                for (int j = 0; j < 4; ++j) t[j] = tw[(k1 * (n2b + 4 * n + j)) & 8191];
#pragma unroll
                for (int bj = 0; bj < 2; ++bj) {
                    const int gm = 16 * gmhi + 8 * bj + 2 * wc + (fq >> 1);
                    const f32x4 ar = acc[0][bj][m][n], ai = acc[1][bj][m][n];
                    u32x4 w;
#pragma unroll
                    for (int j = 0; j < 4; ++j) { const float re = ar[j] * t[j].x + ai[j] * t[j].y, im = ai[j] * t[j].x - ar[j] * t[j].y; w[j] = cvtpk(re, im); }
                    *(u32x4*)(A2t + ((size_t)(k1grp * 512 + b * 256 + gm)) * 512 + (k1lo * 64 + n2b + 4 * n) * 2) = w;
                }
                asm volatile("" ::: "memory");
            }
        }
    }
};

struct EpiF2 {
    static constexpr bool PERM = true;
    bf16_t* Y; int mode;
    __device__ __forceinline__ void operator()(const f32x4 (&acc)[2][2][4][2], const Unit& u, int wr, int wc, int fr_, int fq_) const {
        int fr = fr_, fq = fq_; asm volatile("" : "+v"(fr), "+v"(fq));
#pragma unroll
        for (int ai = 0; ai < 2; ++ai)
#pragma unroll
            for (int m = 0; m < 4; ++m) {
                int row;
                if (mode == 0) { const int k1grp = u.pn >> 1, b = u.pn & 1, k = 4 * k1grp + 2 * ai + wr + 128 * (16 * m + fr); row = b * SEQ + k; }
                else row = NLAT + 256 * u.pn + 128 * ai + 64 * wr + 16 * m + fr;
                bf16_t* rowp = Y + (size_t)row * DM + 768 + 32 * wc + 8 * fq;
#pragma unroll
                for (int bj = 0; bj < 2; ++bj) { const f32x4 v0 = acc[ai][bj][m][0], v1 = acc[ai][bj][m][1]; u32x4 w; w.x = cvtpk(v0[0], v0[1]); w.y = cvtpk(v0[2], v0[3]); w.z = cvtpk(v1[0], v1[1]); w.w = cvtpk(v1[2], v1[3]);
                    *(u32x4*)(rowp + 128 * bj) = w; }
            }
    }
};
__device__ __forceinline__ int crow(int r, int hi) { return (r & 3) + 8 * (r >> 2) + 4 * hi; }
typedef short v4i16_t __attribute__((ext_vector_type(4)));
__device__ __forceinline__ bf16x8 vtr2(const LAS unsigned char* p) {
    const s16x4 lo = __builtin_bit_cast(s16x4, __builtin_amdgcn_ds_read_tr16_b64_v4i16((LAS v4i16_t*)p));
    const s16x4 hi = __builtin_bit_cast(s16x4, __builtin_amdgcn_ds_read_tr16_b64_v4i16((LAS v4i16_t*)(p + 1024)));
    return (bf16x8){lo[0], lo[1], lo[2], lo[3], hi[0], hi[1], hi[2], hi[3]};
}
__device__ __forceinline__ int vsub_off(int key, int dch) { return ((key >> 3) * 2 + (dch >> 2)) * 512 + (key & 7) * 64 + (dch & 3) * 16; }

template <bool LOCAL>
__device__ __forceinline__ void na_tile(LAS unsigned char* vl, const LAS float* brow, const bf16_t* __restrict__ P, int krn, bool more, int h, int lane, int q32, int hi, int trb,
                                        const bf16x8 (&qf)[2][4], const unsigned (&mk)[2], f32x16 (&o)[2][2], float (&lsum)[2]) {
    LAS unsigned char* kl = vl + 8192;
    asm volatile("s_waitcnt vmcnt(8)" ::: "memory");
    bf16x8 kf[2][4];
#pragma unroll
    for (int kb = 0; kb < 2; ++kb)
#pragma unroll
        for (int d0 = 0; d0 < 4; ++d0) { const int key = 32 * kb + q32; kf[kb][d0] = *(const LAS bf16x8*)(kl + key * 128 + (((2 * d0 + hi) ^ ((key >> 1) & 7)) * 16)); }
    f32x16 s[2][2];
#pragma unroll
    for (int qb = 0; qb < 2; ++qb)
#pragma unroll
        for (int kb = 0; kb < 2; ++kb) {
            if (LOCAL) { const LAS float* bp = brow + (4 * hi - (32 * qb + q32) + 15) + 32 * kb;
#pragma unroll
                for (int e = 0; e < 16; ++e) s[qb][kb][e] = bp[(e & 3) + 8 * (e >> 2)]; }
            else {
#pragma unroll
                for (int e = 0; e < 16; ++e) s[qb][kb][e] = 0.f; }
#pragma unroll
            for (int d0 = 0; d0 < 4; ++d0) s[qb][kb] = __builtin_amdgcn_mfma_f32_32x32x16_bf16(kf[kb][d0], qf[qb][d0], s[qb][kb], 0, 0, 0);
        }
    if (more) {
        const int kk = lane >> 3, kc = (lane & 7) ^ ((kk >> 1) & 7);
#pragma unroll
        for (int i = 0; i < 8; ++i)
            __builtin_amdgcn_global_load_lds((const unsigned*)(P + (size_t)(krn + 8 * i + kk) * PP + NAK0 + 64 * h + 8 * (kc ^ ((4 * i) & 7))), (LAS unsigned*)(kl + 1024 * i), 16, 0, 0);
    }
#pragma unroll
    for (int qb = 0; qb < 2; ++qb) {
        bf16x8 pf[4];
#pragma unroll
        for (int kb = 0; kb < 2; ++kb) {
            float pe[16];
#pragma unroll
            for (int e = 0; e < 16; ++e) { float p = __builtin_amdgcn_exp2f(s[qb][kb][e]);
                if (LOCAL) { const int msk = ((int)(mk[qb] << (31 - (16 * kb + e)))) >> 31; p = __builtin_bit_cast(float, __builtin_bit_cast(int, p) & msk); }
                pe[e] = p; lsum[qb] += p; }
#pragma unroll
            for (int hf = 0; hf < 2; ++hf) { u32x4 w; w.x = cvtpk(pe[8 * hf + 0], pe[8 * hf + 1]); w.y = cvtpk(pe[8 * hf + 2], pe[8 * hf + 3]); w.z = cvtpk(pe[8 * hf + 4], pe[8 * hf + 5]); w.w = cvtpk(pe[8 * hf + 6], pe[8 * hf + 7]);
                pf[2 * kb + hf] = __builtin_bit_cast(bf16x8, w); }
        }
        if (qb == 0) { if (more) asm volatile("s_waitcnt vmcnt(8)" ::: "memory"); else asm volatile("s_waitcnt vmcnt(0)" ::: "memory"); }
#pragma unroll
        for (int d0 = 0; d0 < 2; ++d0) { bf16x8 vf[4];
#pragma unroll
            for (int ks = 0; ks < 4; ++ks) vf[ks] = vtr2(vl + trb + (4 * ks + d0) * 512);
#pragma unroll
            for (int ks = 0; ks < 4; ++ks) o[qb][d0] = __builtin_amdgcn_mfma_f32_32x32x16_bf16(vf[ks], pf[ks], o[qb][d0], 0, 0, 0); }
    }
    if (more) {
        asm volatile("s_waitcnt lgkmcnt(0)" ::: "memory");
#pragma unroll
        for (int i = 0; i < 8; ++i)
            __builtin_amdgcn_global_load_lds((const unsigned*)(P + (size_t)(krn + 8 * i + ((lane & 31) >> 2)) * PP + NAV0 + 64 * h + 32 * (lane >> 5) + 8 * (lane & 3)), (LAS unsigned*)(vl + 1024 * i), 16, 0, 0);
    }
}
__device__ __forceinline__ void na_unit(LAS unsigned char* lds, const bf16_t* __restrict__ P, bf16_t* __restrict__ Y, const float* __restrict__ rpb, int qrow0, int b, int r, int wid, int lane_in) {
    int lane = lane_in; asm volatile("" : "+v"(lane));
    const int h = wid, q32 = lane & 31, hi = lane >> 5;
    LAS unsigned char* vl = lds + wid * 17408;
    LAS float* btab = (LAS float*)(vl + 16384);
    int rs = 0;
    unsigned mk[2] = {0u, 0u};
    if (r >= 0) {
        rs = r - 4; rs = rs < 0 ? 0 : (rs > 120 ? 120 : rs);
#pragma unroll
        for (int i = 0; i < 4; ++i) { const int e = lane + 64 * i, kt = e >> 5, rel = e & 31, dr = rs + kt - r + 7; btab[e] = rel < 31 ? rpb[(h * 15 + dr) * 31 + rel] * LOG2E : 0.f; }
#pragma unroll
        for (int qb = 0; qb < 2; ++qb) { const int c = 32 * qb + q32; int cs = c - 8; cs = cs < 0 ? 0 : (cs > 48 ? 48 : cs);
#pragma unroll
            for (int bit = 0; bit < 32; ++bit) { const int kc = 32 * (bit >> 4) + crow(bit & 15, hi); if ((unsigned)(kc - cs) < 16u) mk[qb] |= (1u << bit); } }
    }
    bf16x8 qf[2][4];
#pragma unroll
    for (int qb = 0; qb < 2; ++qb)
#pragma unroll
        for (int d0 = 0; d0 < 4; ++d0) qf[qb][d0] = *(const bf16x8*)(P + (size_t)(qrow0 + 32 * qb + q32) * PP + NAQ0 + 64 * h + 16 * d0 + 8 * hi);
    f32x16 o[2][2]; float lsum[2] = {0.f, 0.f};
#pragma unroll
    for (int a = 0; a < 2; ++a)
#pragma unroll
        for (int d = 0; d < 2; ++d)
#pragma unroll
            for (int e = 0; e < 16; ++e) o[a][d][e] = 0.f;
    const int trb = (4 * hi + ((lane & 15) >> 2)) * 64 + (((lane >> 4) & 1) * 16 + (lane & 3) * 4) * 2;
    const int nloc = (r >= 0) ? 8 : 0, ntiles = nloc + 4;
#define NA_ROW0(t_) ((t_) < nloc ? b * SEQ + 64 * (rs + (t_)) : NLAT + b * CTXL + 64 * ((t_) - nloc))
    {
        const int kr0 = NA_ROW0(0); const int kk = lane >> 3, kc = (lane & 7) ^ ((kk >> 1) & 7);
#pragma unroll
        for (int i = 0; i < 8; ++i)
            __builtin_amdgcn_global_load_lds((const unsigned*)(P + (size_t)(kr0 + 8 * i + kk) * PP + NAK0 + 64 * h + 8 * (kc ^ ((4 * i) & 7))), (LAS unsigned*)(vl + 8192 + 1024 * i), 16, 0, 0);
#pragma unroll
        for (int i = 0; i < 8; ++i)
            __builtin_amdgcn_global_load_lds((const unsigned*)(P + (size_t)(kr0 + 8 * i + ((lane & 31) >> 2)) * PP + NAV0 + 64 * h + 32 * (lane >> 5) + 8 * (lane & 3)), (LAS unsigned*)(vl + 1024 * i), 16, 0, 0);
    }
    for (int t = 0; t < nloc; ++t) na_tile<true>(vl, btab + t * 32, P, NA_ROW0(t + 1), true, h, lane, q32, hi, trb, qf, mk, o, lsum);
    for (int t = nloc; t < ntiles; ++t) na_tile<false>(vl, btab, P, NA_ROW0(t + 1), t + 1 < ntiles, h, lane, q32, hi, trb, qf, mk, o, lsum);
#undef NA_ROW0
#pragma unroll
    for (int qb = 0; qb < 2; ++qb) {
        const float l = sum_xor32(lsum[qb]); const float rl = 1.f / l;
        bf16_t* yp = Y + (size_t)(qrow0 + 32 * qb + q32) * DM + 64 * h + 4 * hi;
#pragma unroll
        for (int d0 = 0; d0 < 2; ++d0)
#pragma unroll
            for (int g4 = 0; g4 < 4; ++g4) { u32x2 w; w.x = cvtpk(o[qb][d0][4 * g4] * rl, o[qb][d0][4 * g4 + 1] * rl); w.y = cvtpk(o[qb][d0][4 * g4 + 2] * rl, o[qb][d0][4 * g4 + 3] * rl);
                *(u32x2*)(yp + 32 * d0 + 8 * g4) = w; }
    }
}

#define DU_ROW(t_) ((size_t)(((t_) < 128 ? b * SEQ + 64 * (t_) : NLAT + b * CTXL + 64 * ((t_) - 128)) + skey) * PP)
#define DU_TILE(BUF) do { \
        bf16x8 p1[4], p2[4]; \
        _Pragma("unroll") for (int c = 0; c < 2; ++c) { \
            _Pragma("unroll") for (int kb = 0; kb < 2; ++kb) { \
                const int key = 32 * kb + q32; \
                f32x16 s; \
                _Pragma("unroll") for (int e = 0; e < 16; ++e) s[e] = 0.f; \
                _Pragma("unroll") for (int d0 = 0; d0 < 2; ++d0) { const int ch = 4 * c + 2 * d0 + hi; const bf16x8 kf = *(const LAS bf16x8*)((BUF) + key * 128 + ((ch ^ ((key >> 1) & 7)) * 16)); \
                    s = __builtin_amdgcn_mfma_f32_32x32x16_bf16(kf, qf[c][d0], s, 0, 0, 0); } \
                float pe[16]; float ls = 0.f; \
                _Pragma("unroll") for (int e = 0; e < 16; ++e) { pe[e] = __builtin_amdgcn_exp2f(s[e]); ls += pe[e]; } \
                if (c == 0) l1 += ls; else l2 += ls; \
                _Pragma("unroll") for (int hf = 0; hf < 2; ++hf) { u32x4 w; w.x = cvtpk(pe[8 * hf + 0], pe[8 * hf + 1]); w.y = cvtpk(pe[8 * hf + 2], pe[8 * hf + 3]); w.z = cvtpk(pe[8 * hf + 4], pe[8 * hf + 5]); w.w = cvtpk(pe[8 * hf + 6], pe[8 * hf + 7]); \
                    if (c == 0) p1[2 * kb + hf] = __builtin_bit_cast(bf16x8, w); else p2[2 * kb + hf] = __builtin_bit_cast(bf16x8, w); } \
            } \
        } \
        _Pragma("unroll") for (int d0 = 0; d0 < 2; ++d0) \
            _Pragma("unroll") for (int ks = 0; ks < 4; ++ks) { const bf16x8 vf = vtr2((BUF) + trb + (4 * ks + d0) * 512); \
                o1[d0] = __builtin_amdgcn_mfma_f32_32x32x16_bf16(vf, p1[ks], o1[d0], 0, 0, 0); o2[d0] = __builtin_amdgcn_mfma_f32_32x32x16_bf16(vf, p2[ks], o2[d0], 0, 0, 0); } \
    } while (0)
__device__ __forceinline__ void diff_unit(LAS unsigned char* lds, const bf16_t* __restrict__ P, bf16_t* __restrict__ Y, const float* __restrict__ subg, int qrow0, int b, int h, int t0, int t1, float lam, float oscale, int tid_in) {
    int tid = tid_in; asm volatile("" : "+v"(tid));
    const int lane = tid & 63, wid = tid >> 6, q32 = lane & 31, hi = lane >> 5;
    const int qrow = qrow0 + 32 * wid + q32;
    bf16x8 qf[2][2];
#pragma unroll
    for (int c = 0; c < 2; ++c)
#pragma unroll
        for (int d0 = 0; d0 < 2; ++d0) qf[c][d0] = *(const bf16x8*)(P + (size_t)qrow * PP + DQ0 + 64 * h + 32 * c + 16 * d0 + 8 * hi);
    const int trb = 8192 + (4 * hi + ((lane & 15) >> 2)) * 64 + (((lane >> 4) & 1) * 16 + (lane & 3) * 4) * 2;
    f32x16 o1[2], o2[2]; float l1 = 0.f, l2 = 0.f;
#pragma unroll
    for (int d = 0; d < 2; ++d)
#pragma unroll
        for (int e = 0; e < 16; ++e) { o1[d][e] = 0.f; o2[d][e] = 0.f; }
    const int kkey = 8 * wid + (lane >> 3), kch = (lane & 7) ^ ((kkey >> 1) & 7);
    const size_t koff = (size_t)kkey * PP + DK0 + 64 * h + 8 * kch, voff = (size_t)(8 * wid + ((lane & 31) >> 2)) * PP + DV0 + 64 * h + 32 * (lane >> 5) + 8 * (lane & 3);
#define DU_DMA(tt, sl) do { const size_t r_ = (size_t)((tt) < 128 ? b * SEQ + 64 * (tt) : NLAT + b * CTXL + 64 * ((tt) - 128)) * PP; \
        __builtin_amdgcn_global_load_lds((const unsigned*)(P + r_ + koff), (LAS unsigned*)(lds + (sl) * 16384 + wid * 1024), 16, 0, 0); \
        __builtin_amdgcn_global_load_lds((const unsigned*)(P + r_ + voff), (LAS unsigned*)(lds + (sl) * 16384 + 8192 + wid * 1024), 16, 0, 0); } while (0)
    DU_DMA(t0, 0); DU_DMA(t0 + 1, 1);
    asm volatile("s_waitcnt vmcnt(2)" ::: "memory"); __builtin_amdgcn_s_barrier(); asm volatile("" ::: "memory");
    int slot = 0;
    for (int t = t0; t < t1; ++t) {
        const int s2 = slot == 0 ? 2 : slot - 1;
        if (t + 2 < t1) DU_DMA(t + 2, s2);
        { LAS unsigned char* buf = lds + slot * 16384; DU_TILE(buf); }
        if (t + 2 < t1) asm volatile("s_waitcnt vmcnt(2)" ::: "memory"); else asm volatile("s_waitcnt vmcnt(0)" ::: "memory");
        __builtin_amdgcn_s_barrier(); asm volatile("" ::: "memory");
        slot = slot == 2 ? 0 : slot + 1;
    }
#undef DU_DMA
    l1 = sum_xor32(l1); l2 = sum_xor32(l2);
    const float r1 = 1.f / l1, r2 = lam / l2;
    float ss = 0.f;
#pragma unroll
    for (int d0 = 0; d0 < 2; ++d0)
#pragma unroll
        for (int e = 0; e < 16; ++e) { const float v = o1[d0][e] * r1 - o2[d0][e] * r2; o1[d0][e] = v; ss += v * v; }
    ss = sum_xor32(ss);
    const float rstd = __builtin_amdgcn_rsqf(ss * (1.f / 64.f) + EPS) * oscale;
    bf16_t* yp = Y + (size_t)qrow * DM + 512 + 64 * h + 4 * hi;
    const float* sg = subg; asm volatile("" : "+s"(sg));
#pragma unroll
    for (int d0 = 0; d0 < 2; ++d0)
#pragma unroll
        for (int g4 = 0; g4 < 4; ++g4) { const f32x4 gg = *(const f32x4*)(sg + 32 * d0 + 8 * g4 + 4 * hi);
            u32x2 w; w.x = cvtpk(o1[d0][4 * g4] * rstd * gg[0], o1[d0][4 * g4 + 1] * rstd * gg[1]); w.y = cvtpk(o1[d0][4 * g4 + 2] * rstd * gg[2], o1[d0][4 * g4 + 3] * rstd * gg[3]);
            *(u32x2*)(yp + 32 * d0 + 8 * g4) = w; }
}
#undef DU_TILE
#undef DU_ROW

__device__ __forceinline__ float fadd_s(float a, float b) { float r; asm("v_add_f32_e32 %0, %1, %2" : "=v"(r) : "v"(a), "v"(b)); return r; }
#define DF_EXP(S0, S1, PF, LSUM) do { \
    _Pragma("unroll") for (int kb_ = 0; kb_ < 2; ++kb_) { float pe_[16]; \
        _Pragma("unroll") for (int e_ = 0; e_ < 16; ++e_) { pe_[e_] = __builtin_amdgcn_exp2f(kb_ == 0 ? S0[e_] : S1[e_]); LSUM += pe_[e_]; asm volatile("" : "+v"(LSUM)); } \
        _Pragma("unroll") for (int hf_ = 0; hf_ < 2; ++hf_) { u32x4 w_; w_.x = cvtpk(pe_[8 * hf_ + 0], pe_[8 * hf_ + 1]); w_.y = cvtpk(pe_[8 * hf_ + 2], pe_[8 * hf_ + 3]); w_.z = cvtpk(pe_[8 * hf_ + 4], pe_[8 * hf_ + 5]); w_.w = cvtpk(pe_[8 * hf_ + 6], pe_[8 * hf_ + 7]); \
            PF[2 * kb_ + hf_] = __builtin_bit_cast(bf16x8, w_); } } } while (0)
#define DF_S2(C, DST0, DST1, KBUF) do { bf16x8 kf_[2][2]; \
    _Pragma("unroll") for (int kb_ = 0; kb_ < 2; ++kb_) _Pragma("unroll") for (int d0_ = 0; d0_ < 2; ++d0_) { const int key_ = 32 * kb_ + q32; \
        kf_[kb_][d0_] = *(const LAS bf16x8*)((KBUF) + key_ * 128 + (((4 * (C) + 2 * d0_ + hi) ^ ((key_ >> 1) & 7)) * 16)); } \
    DST0 = __builtin_amdgcn_mfma_f32_32x32x16_bf16(kf_[0][0], qf[C][0], Z, 0, 0, 0); DST1 = __builtin_amdgcn_mfma_f32_32x32x16_bf16(kf_[1][0], qf[C][0], Z, 0, 0, 0); \
    DST0 = __builtin_amdgcn_mfma_f32_32x32x16_bf16(kf_[0][1], qf[C][1], DST0, 0, 0, 0); DST1 = __builtin_amdgcn_mfma_f32_32x32x16_bf16(kf_[1][1], qf[C][1], DST1, 0, 0, 0); } while (0)
#define DF_PV(O, PF, VBUF) do { bf16x8 vf_[2][4]; \
    _Pragma("unroll") for (int d0_ = 0; d0_ < 2; ++d0_) _Pragma("unroll") for (int ks_ = 0; ks_ < 4; ++ks_) vf_[d0_][ks_] = vtr2((VBUF) + trb + (4 * ks_ + d0_) * 512); \
    _Pragma("unroll") for (int ks_ = 0; ks_ < 4; ++ks_) _Pragma("unroll") for (int d0_ = 0; d0_ < 2; ++d0_) O[d0_] = __builtin_amdgcn_mfma_f32_32x32x16_bf16(vf_[d0_][ks_], PF[ks_], O[d0_], 0, 0, 0); } while (0)
__device__ __forceinline__ void diff_unit2(LAS unsigned char* lds, const bf16_t* __restrict__ P, bf16_t* __restrict__ Y, const float* __restrict__ subg, int qrow0, int b, int h, int t0, int t1, float lam, float oscale, int tid_in) {
    int tid = tid_in; asm volatile("" : "+v"(tid));
    const int lane = tid & 63, wid = tid >> 6, q32 = lane & 31, hi = lane >> 5;
    const int qrow = qrow0 + 32 * wid + q32;
    bf16x8 qf[2][2];
#pragma unroll
    for (int c = 0; c < 2; ++c)
#pragma unroll
        for (int d0 = 0; d0 < 2; ++d0) qf[c][d0] = *(const bf16x8*)(P + (size_t)qrow * PP + DQ0 + 64 * h + 32 * c + 16 * d0 + 8 * hi);
    const int skey = tid >> 3, sch = tid & 7;
    const int kdst = skey * 128 + ((sch ^ ((skey >> 1) & 7)) * 16), vdst = 16384 + vsub_off(skey, sch);
    const int trb = (4 * hi + ((lane & 15) >> 2)) * 64 + (((lane >> 4) & 1) * 16 + (lane & 3) * 4) * 2;
    f32x16 Z; { float z0 = 0.f; asm volatile("" : "+v"(z0));
#pragma unroll
    for (int e = 0; e < 16; ++e) Z[e] = z0; }
    asm volatile("" : "+v"(Z));
    f32x16 o1[2], o2[2]; float l1 = 0.f, l2 = 0.f;
#pragma unroll
    for (int d = 0; d < 2; ++d) { o1[d] = Z; o2[d] = Z; }
    const bf16_t* kg = P + DK0 + 64 * h + 8 * sch; const bf16_t* vg = P + DV0 + 64 * h + 8 * sch;
#define DF_ROW(t_) ((size_t)(((t_) < 128 ? b * SEQ + 64 * (t_) : NLAT + b * CTXL + 64 * ((t_) - 128)) + skey) * PP)
    u32x4 rk, rv;
    rk = *(const u32x4*)(kg + DF_ROW(t0)); rv = *(const u32x4*)(vg + DF_ROW(t0));
    *(LAS u32x4*)(lds + kdst) = rk; *(LAS u32x4*)(lds + vdst) = rv;
    rk = *(const u32x4*)(kg + DF_ROW(t0 + 1));
    *(LAS u32x4*)(lds + 8192 + kdst) = rk;
    __syncthreads();
    f32x16 sA0, sA1, sB0, sB1; bf16x8 p1[4], p2[4];
    DF_S2(0, sA0, sA1, lds); DF_S2(1, sB0, sB1, lds);
    __syncthreads();
    DF_EXP(sA0, sA1, p1, l1);
    for (int t = t0; t < t1; ++t) {
        const int it = t - t0; const bool more = (t + 1 < t1);
        LAS unsigned char* kb1 = lds + ((it + 1) & 1) * 8192;
        LAS unsigned char* vb0 = lds + 16384 + (it & 1) * 8192;
        if (t + 2 < t1) rk = *(const u32x4*)(kg + DF_ROW(t + 2));
        if (more) rv = *(const u32x4*)(vg + DF_ROW(t + 1));
        __builtin_amdgcn_sched_barrier(0);
        if (more) { DF_S2(0, sA0, sA1, kb1); }
        DF_PV(o1, p1, vb0);
        DF_EXP(sB0, sB1, p2, l2);
        __builtin_amdgcn_sched_barrier(0);
        DF_PV(o2, p2, vb0);
        if (more) { DF_S2(1, sB0, sB1, kb1); DF_EXP(sA0, sA1, p1, l1); }
        __builtin_amdgcn_sched_barrier(0);
        if (t + 2 < t1) *(LAS u32x4*)(lds + (it & 1) * 8192 + kdst) = rk;
        if (more) *(LAS u32x4*)(lds + ((it + 1) & 1) * 8192 + vdst) = rv;
        __syncthreads();
    }
#undef DF_ROW
    l1 = sum_xor32(l1); l2 = sum_xor32(l2);
    const float r1 = 1.f / l1, r2 = lam / l2;
    float ss = 0.f;
#pragma unroll
    for (int d0 = 0; d0 < 2; ++d0)
#pragma unroll
        for (int e = 0; e < 16; ++e) { const float v = o1[d0][e] * r1 - o2[d0][e] * r2; o1[d0][e] = v; ss += v * v; }
    ss = sum_xor32(ss);
    const float rstd = __builtin_amdgcn_rsqf(ss * (1.f / 64.f) + EPS) * oscale;
    bf16_t* yp = Y + (size_t)qrow * DM + 512 + 64 * h + 4 * hi;
    const float* sg = subg; asm volatile("" : "+s"(sg));
#pragma unroll
    for (int d0 = 0; d0 < 2; ++d0)
#pragma unroll
        for (int g4 = 0; g4 < 4; ++g4) { const f32x4 gg = *(const f32x4*)(sg + 32 * d0 + 8 * g4 + 4 * hi);
            u32x2 w; w.x = cvtpk(o1[d0][4 * g4] * rstd * gg[0], o1[d0][4 * g4 + 1] * rstd * gg[1]); w.y = cvtpk(o1[d0][4 * g4 + 2] * rstd * gg[2], o1[d0][4 * g4 + 3] * rstd * gg[3]);
            *(u32x2*)(yp + 32 * d0 + 8 * g4) = w; }
}
constexpr size_t MiB = 1u << 20;
constexpr size_t WS_MOD = 0, WS_LAM = 160 * 1024, WS_BAR = 176 * 1024, WS_ROPE = 192 * 1024, WS_TW = 256 * 1024, WS_M1 = 384 * 1024, WS_M2 = 512 * 1024, WS_MC = 768 * 1024;
constexpr size_t WS_W = 1 * MiB, W_LAYER = 24 * MiB, WO_IN = 0, WO_OUT = 5632 * 1024, WO_UP = WO_OUT + 2 * MiB, WO_DN = WO_UP + 11 * MiB;
constexpr size_t WS_XC = 49 * MiB, WS_XN = 51 * MiB, WS_P = 85 * MiB, WS_ZT = 160 * MiB, WS_ZTC = 176 * MiB, WS_A2T = 177 * MiB, WS_Y = 193 * MiB, WS_A2 = 85 * MiB, WS_PART = 228 * MiB, WS_END = 252 * MiB;
static_assert(WO_DN + (size_t)1024 * 2816 * 2 <= W_LAYER, "weights");
static_assert(WS_XN + (size_t)(1 + MT + 256) * DM * 2 <= WS_P && WS_P + (size_t)MT * PP * 2 <= WS_ZT && WS_A2 + (size_t)MT * DFF * 2 <= WS_Y && WS_Y + (size_t)MT * DM * 2 <= WS_PART && WS_PART + (size_t)11 * 512 * DM * 4 <= WS_END, "ws map");

struct Args { const float* in[22]; float* out; unsigned char* ws; };

__device__ __forceinline__ void tr_item(const float* __restrict__ src, int ld, int k0, int c0, bf16_t* __restrict__ dst, int dK, int r0, bool perm, LAS float* scr, int lane) {
#pragma unroll 8
    for (int i = 0; i < 32; ++i) { const int kk = 2 * i + (lane >> 5); scr[kk * 33 + (lane & 31)] = src[(size_t)(k0 + kk) * ld + c0 + (lane & 31)]; }
    const int c = lane & 7;
#pragma unroll
    for (int j = 0; j < 4; ++j) { const int n = (lane >> 3) + 8 * j; const int sn = perm ? dimperm(n) : n; const LAS float* s = scr + (8 * c) * 33 + sn;
        u32x4 o; o.x = cvtpk(s[0 * 33], s[1 * 33]); o.y = cvtpk(s[2 * 33], s[3 * 33]); o.z = cvtpk(s[4 * 33], s[5 * 33]); o.w = cvtpk(s[6 * 33], s[7 * 33]);
        *(u32x4*)(dst + (size_t)(r0 + n) * dK + k0 + 8 * c) = o; }
}

__device__ __forceinline__ void tr_item64(const float* __restrict__ src, int ld, int k0, int c0, bf16_t* __restrict__ dst, int dK, int ra, int rb, bool perm, LAS float* scr, int lane) {
    f32x4 v[16];
    const float* sp = src + (size_t)(k0 + (lane >> 4)) * ld + c0 + 4 * (lane & 15);
#pragma unroll
    for (int i = 0; i < 16; ++i) v[i] = *(const f32x4*)(sp + (size_t)(4 * i) * ld);
#pragma unroll
    for (int i = 0; i < 16; ++i) { LAS float* w = scr + (4 * i + (lane >> 4)) * 65 + 4 * (lane & 15); w[0] = v[i][0]; w[1] = v[i][1]; w[2] = v[i][2]; w[3] = v[i][3]; }
    const int c = lane & 7;
#pragma unroll
    for (int j = 0; j < 8; ++j) { const int n = (lane >> 3) + 8 * j, i32 = n & 31; const int sn = (n & 32) + (perm ? dimperm(i32) : i32); const LAS float* s = scr + (8 * c) * 65 + sn;
        u32x4 o; o.x = cvtpk(s[0 * 65], s[1 * 65]); o.y = cvtpk(s[2 * 65], s[3 * 65]); o.z = cvtpk(s[4 * 65], s[5 * 65]); o.w = cvtpk(s[6 * 65], s[7 * 65]);
        *(u32x4*)(dst + (size_t)((n < 32 ? ra : rb) + i32) * dK + k0 + 8 * c) = o; }
}

__device__ __forceinline__ float silu_f(float x) { return x / (1.f + __expf(-x)); }

__device__ __forceinline__ void prep_phase(const Args& a, LAS unsigned char* lds, int tid_in, int bx, int G) {
    int tid = tid_in; asm volatile("" : "+v"(tid));
    unsigned char* ws = a.ws;
    const int lane = tid & 63, wave = __builtin_amdgcn_readfirstlane(tid >> 6);
#ifndef REP_PB
#define REP_PB 1
#endif
#ifndef REP_PT
#define REP_PT 1
#endif
#ifndef REP_PX
#define REP_PX 1
#endif
    for (int rp = 0; rp < REP_PB; ++rp) {
    const int nslots = (G == 256) ? 2 : (448 + G - 1) / G;
    for (int slot = 0; slot < nslots; ++slot) {
        int it;
        if (G == 256) { if (bx < 128) it = slot == 0 ? bx : (bx < 64 ? 128 + bx : -1); else it = slot == 0 ? 320 + (bx - 128) : 192 + (bx - 128); }
        else { it = bx + slot * G; if (it >= 448) it = -1; }
        if (it < 0) continue;
        __syncthreads();
        if (it < 192) {
            const int l = it / 96, n0 = 64 * (it % 96);
            LAS float* sv = (LAS float*)lds; LAS float* red = sv + 3072;
            for (int e = tid; e < 3072; e += 512) { const int v = e >> 10, k = e & 1023; sv[e] = silu_f(v < 2 ? a.in[1][v * 1024 + k] : a.in[3][k]); }
            __syncthreads();
            const int cq = tid & 15, kg = tid >> 4;
            f32x4 ac[3] = {{0.f, 0.f, 0.f, 0.f}, {0.f, 0.f, 0.f, 0.f}, {0.f, 0.f, 0.f, 0.f}};
            const float* wp = a.in[4] + (size_t)l * 1024 * 6144 + n0 + 4 * cq;
#pragma unroll 8
            for (int i = 0; i < 32; ++i) { const int k = kg + 32 * i; const f32x4 w = *(const f32x4*)(wp + (size_t)k * 6144); ac[0] += w * sv[k]; ac[1] += w * sv[1024 + k]; ac[2] += w * sv[2048 + k]; }
#pragma unroll
            for (int v = 0; v < 3; ++v)
#pragma unroll
                for (int e = 0; e < 4; ++e) red[(kg * 16 + cq) * 12 + v * 4 + e] = ac[v][e];
            __syncthreads();
            if (tid < 192) { const int v = tid >> 6, n = tid & 63; float s = a.in[5][l * 6144 + n0 + n];
                for (int g = 0; g < 32; ++g) s += red[(g * 16 + (n >> 2)) * 12 + v * 4 + (n & 3)];
                ((float*)(ws + WS_MOD))[(l * 3 + v) * 6144 + n0 + n] = s; }
            asm volatile("s_waitcnt vmcnt(0)" ::: "memory"); __syncthreads();
            if (tid == 0) { __builtin_amdgcn_fence(__ATOMIC_RELEASE, "agent"); asm volatile("s_waitcnt vmcnt(0)" ::: "memory"); xb_add((unsigned*)(ws + WS_BAR) + 3648, 1u); }
        } else if (it < 320) {
            const int q = it - 192, l = q >> 6, g = (q >> 4) & 3, k0 = 64 * (q & 15);
            LAS float* wt = (LAS float*)lds; LAS float* ct = wt + 64 * 65; LAS float* st = ct + 64;
            for (int e = tid; e < 4096; e += 512) { const int k = e >> 6, j = e & 63; wt[k * 65 + j] = a.in[7][((size_t)l * 1024 + k0 + k) * INW + FN0 + 64 * g + j]; }
            if (tid < 64) { ct[tid] = cospif((float)tid / 32.f) * 0.125f; st[tid] = -sinpif((float)tid / 32.f) * 0.125f; }
            __syncthreads();
            bf16_t* dst = (bf16_t*)(ws + WS_W + l * W_LAYER + WO_IN);
            {
                const int k = lane, c = wave & 1, m0 = wave >> 1;
                const float tl = c ? st[lane] : ct[lane];
                float s[16];
#pragma unroll
                for (int i = 0; i < 16; ++i) s[i] = 0.f;
#pragma unroll 4
                for (int j = 0; j < 64; ++j) { const float w = wt[k * 65 + j];
#pragma unroll
                    for (int i = 0; i < 16; ++i) s[i] += w * __builtin_bit_cast(float, __builtin_amdgcn_readlane(__builtin_bit_cast(int, tl), ((m0 + 4 * i) * j) & 63)); }
#pragma unroll
                for (int i = 0; i < 16; ++i) dst[(size_t)(2304 + 128 * g + wave + 8 * i) * 1024 + k0 + k] = f2bf(s[i]);
            }
        } else {
            const int q = it - 320, l = q >> 6, n0 = 16 * (q & 63);
            LAS float* wo = (LAS float*)lds; LAS float* wf = wo + 256 * 20;
            for (int e = tid; e < 4096; e += 512) { const int j = e >> 4, nn = e & 15; wo[j * 20 + nn] = a.in[16][((size_t)l * 1024 + 768 + j) * 1024 + n0 + nn]; }
            const int i = tid & 255, nh = tid >> 8;
            float acc[8];
#pragma unroll
            for (int e = 0; e < 8; ++e) acc[e] = 0.f;
            for (int j0 = 0; j0 < 256; j0 += 32) {
                __syncthreads();
                for (int e = tid; e < 8192; e += 512) { const int ii = e >> 5, jj = e & 31; wf[ii * 33 + jj] = a.in[15][((size_t)l * 256 + ii) * 256 + j0 + jj]; }
                __syncthreads();
                for (int jj = 0; jj < 32; ++jj) { const float w = wf[i * 33 + jj]; const LAS f32x4* wr_ = (const LAS f32x4*)(wo + (j0 + jj) * 20 + 8 * nh);
#pragma unroll
                    for (int e4 = 0; e4 < 2; ++e4) { const f32x4 wv = wr_[e4];
#pragma unroll
                        for (int e = 0; e < 4; ++e) acc[4 * e4 + e] += w * wv[e]; } }
            }
            bf16_t* dst = (bf16_t*)(ws + WS_W + l * W_LAYER + WO_OUT);
#pragma unroll
            for (int e = 0; e < 8; ++e) dst[(size_t)(n0 + 8 * nh + e) * 1024 + 768 + i] = f2bf(acc[e]);
        }
    }
    }
    __syncthreads();
    {
        LAS float* scr = (LAS float*)(lds + wave * 16640);
        const int gw = bx * 8 + wave, NGW = G * 8;
        constexpr int I_IN = 16 * 36, I_OUT = 12 * 16, I_UP = 16 * 88, I_DN = 44 * 16, I_L = I_IN + I_OUT + I_UP + I_DN;
        const bool heavy = (G == 256) && bx >= 128;
        constexpr int HV_N = 1536;
        const int it0 = (G != 256) ? gw : (heavy ? gw - 1024 : HV_N + (1023 - gw)), itS = (G != 256) ? NGW : 1024, itE = (G != 256) ? 2 * I_L : (heavy ? HV_N : 2 * I_L);
        for (int rp = 0; rp < REP_PT; ++rp)
        for (int it = it0; it < itE; it += itS) {
            const int l = it / I_L; int r = it % I_L;
            unsigned char* wl = ws + WS_W + l * W_LAYER;
            if (r < I_IN) { const int kb = r / 36, sb = r % 36, pn = sb >> 2, wc = sb & 3;
                tr_item64(a.in[7] + (size_t)l * 1024 * INW, INW, 64 * kb, 256 * pn + 64 * wc, (bf16_t*)(wl + WO_IN), 1024, 256 * pn + 32 * wc, 256 * pn + 128 + 32 * wc, pn == 6 || pn == 7, scr, lane); continue; }
            r -= I_IN;
            if (r < I_OUT) { const int kb = r / 16, nb = r % 16;
                tr_item64(a.in[16] + (size_t)l * 1024 * 1024, 1024, 64 * kb, 64 * nb, (bf16_t*)(wl + WO_OUT), 1024, 64 * nb, 64 * nb + 32, false, scr, lane); continue; }
            r -= I_OUT;
            if (r < I_UP) { const int kb = r / 88, sb = r % 88, half = sb / 44, s = sb % 44; const int d0 = 256 * (s >> 1) + 128 * half + 64 * (s & 1);
                tr_item64(a.in[18] + (size_t)l * 1024 * 5632, 5632, 64 * kb, half * DFF + 64 * s, (bf16_t*)(wl + WO_UP), 1024, d0, d0 + 32, false, scr, lane); continue; }
            r -= I_UP;
            { const int kb = r / 16, nb = r % 16;
                tr_item64(a.in[21] + (size_t)l * DFF * 1024, 1024, 64 * kb, 64 * nb, (bf16_t*)(wl + WO_DN), DFF, 64 * nb, 64 * nb + 32, false, scr, lane); }
        }
    }
    for (int rp = 0; rp < REP_PX; ++rp) {
        const int gt = bx * 512 + tid, NT = G * 512;
        f32x2* rope = (f32x2*)(ws + WS_ROPE);
        for (int e = gt; e < 1024; e += NT) { const int pos = e >> 3, f = e & 7; const float inv = exp2f(-(float)f * (13.287712379549449f / 8.f)); const float ang = (float)pos * inv;
            const double rev = (double)ang * 0.15915494309189535; const float fr = (float)(rev - floor(rev)); rope[e] = (f32x2){cospif(2.f * fr), sinpif(2.f * fr)}; }
        f32x2* tw = (f32x2*)(ws + WS_TW);
        for (int e = gt; e < 8192; e += NT) { const float x = (float)e / 4096.f; tw[e] = (f32x2){cospif(x), sinpif(x)}; }
        bf16_t* m1 = (bf16_t*)(ws + WS_M1);
        for (int e = gt; e < 65536; e += NT) { const int rho = e >> 8, kk = e & 255, cp = rho >> 7, k1 = rho & 127, n1 = kk >> 1, c = kk & 1; const float x = (float)((k1 * n1) & 127) / 64.f;
            const float cs = cospif(x) * 0.08838834764831845f, sn = sinpif(x) * 0.08838834764831845f; m1[e] = f2bf(cp == 0 ? (c == 0 ? cs : sn) : (c == 0 ? -sn : cs)); }
        bf16_t* m2 = (bf16_t*)(ws + WS_M2);
        for (int e = gt; e < 131072; e += NT) { const int rho = e >> 9, kk = e & 511, k1lo = rho >> 6, k2 = rho & 63, kl2 = kk >> 7, n2 = (kk >> 1) & 63, c = kk & 1; const float x = (float)((k2 * n2) & 63) / 32.f;
            m2[e] = f2bf(kl2 == k1lo ? (c == 0 ? cospif(x) : sinpif(x)) * 0.125f : 0.f); }
        bf16_t* mc = (bf16_t*)(ws + WS_MC);
        for (int e = gt; e < 131072; e += NT) { const int k = e >> 9, kk = e & 511, n = kk >> 1, c = kk & 1; const float x = (float)((k * n) & 255) / 128.f; mc[e] = f2bf((c == 0 ? cospif(x) : sinpif(x)) * 0.0625f); }
        if (gt < 2) { const float* dl = a.in[13] + gt * 128; float s1 = 0.f, s2 = 0.f; for (int i = 0; i < 32; ++i) { s1 += dl[i] * dl[32 + i]; s2 += dl[64 + i] * dl[96 + i]; }
            const float li = 0.8f - 0.6f * expf(-0.3f * (float)gt); float* lm = (float*)(ws + WS_LAM); lm[2 * gt] = expf(s1) - expf(s2) + li; lm[2 * gt + 1] = 1.f - li; }
    }
}

__device__ __forceinline__ void norm_row(const float* __restrict__ xr, bf16_t* __restrict__ orow, const f32x4 (&gs)[4], const f32x4 (&sh)[4], int lane, float* cp, const float* part, int nparts) {
    f32x4 v[4]; float s = 0.f;
#pragma unroll
    for (int j = 0; j < 4; ++j) { v[j] = *(const f32x4*)(xr + 4 * lane + 256 * j);
        for (int p = 0; p < nparts; ++p) v[j] += *(const f32x4*)(part + (size_t)p * (512 * DM) + 4 * lane + 256 * j);
        if (cp) *(f32x4*)(cp + 4 * lane + 256 * j) = v[j]; s += (v[j][0] * v[j][0] + v[j][1] * v[j][1]) + (v[j][2] * v[j][2] + v[j][3] * v[j][3]); }
    s += SWZ_XOR(s, 1); s += SWZ_XOR(s, 2); s += SWZ_XOR(s, 4); s += SWZ_XOR(s, 8); s += SWZ_XOR(s, 16); s = sum_xor32(s);
    const float rstd = __builtin_amdgcn_rsqf(s * (1.f / 1024.f) + EPS);
#pragma unroll
    for (int j = 0; j < 4; ++j) { const f32x4 y = v[j] * rstd * gs[j] + sh[j]; u32x2 w; w.x = cvtpk(y[0], y[1]); w.y = cvtpk(y[2], y[3]); *(u32x2*)(orow + 4 * lane + 256 * j) = w; }
}
__device__ __forceinline__ void norm_phase(const float* xlat, const float* xctx, const float* g, const float* modl, int sh_off, int sc_off, bf16_t* XN, bool do_ctx, int gw, int NGW, int lane_in, float* ctx_copy, const float* part, int nparts) {
    int lane = lane_in; asm volatile("" : "+v"(lane));
    for (int ch = gw; ch < 2048; ch += NGW) {
        const int v = ch < 1024 ? 0 : 1;
        f32x4 gs[4], sh[4];
#pragma unroll
        for (int j = 0; j < 4; ++j) { const int c = 4 * lane + 256 * j; gs[j] = *(const f32x4*)(g + c) * (*(const f32x4*)(modl + v * 6144 + sc_off + c) + 1.f); sh[j] = *(const f32x4*)(modl + v * 6144 + sh_off + c); }
        for (int i = 0; i < 8; ++i) { const int row = 8 * ch + i; norm_row(xlat + (size_t)row * DM, XN + (size_t)row * DM, gs, sh, lane, nullptr, nullptr, 0); }
    }
    if (do_ctx) {
        for (int rc = NGW - 1 - gw; rc < 2 * CTXL; rc += NGW) {
            f32x4 gs[4], sh[4];
#pragma unroll
            for (int j = 0; j < 4; ++j) { const int c = 4 * lane + 256 * j; gs[j] = *(const f32x4*)(g + c) * (*(const f32x4*)(modl + 2 * 6144 + sc_off + c) + 1.f); sh[j] = *(const f32x4*)(modl + 2 * 6144 + sh_off + c); }
            norm_row(xctx + (size_t)rc * DM, XN + (size_t)(NLAT + rc) * DM, gs, sh, lane, ctx_copy ? ctx_copy + (size_t)rc * DM : nullptr, part + (size_t)rc * DM, nparts);
        }
    }
}
constexpr int LDS_BYTES = 147456;

#ifndef REP_DIFF
#define REP_DIFF 1
#endif
#ifndef REP_NA
#define REP_NA 1
#endif
#ifndef REP_SYNC
#define REP_SYNC 1
#endif
#ifndef REP_PREP
#define REP_PREP 1
#endif
#ifndef REP_UP
#define REP_UP 1
#endif
#ifndef REP_WIN
#define REP_WIN 1
#endif
#ifndef REP_NORM
#define REP_NORM 1
#endif
#define GSYNC() do { for (int _r = 0; _r < REP_SYNC; ++_r) { XcdBarrier xb_ = xbar; { typedef __attribute__((address_space(1))) unsigned gu32_; gu32_* bp_ = (gu32_*)xb_.bar; asm volatile("" : "+s"(bp_)); xb_.bar = (unsigned*)bp_; } xcd_barrier(xb_, wave == 0 && lane_fresh() == 0); } } while (0)
#ifndef SPLITK
#define SPLITK 0
#endif
__global__ void __launch_bounds__(512, 2) hyb_fwd(Args a) {
    extern __shared__ __attribute__((aligned(16))) unsigned char lds_raw[];
    LAS unsigned char* lds = (LAS unsigned char*)lds_raw;
    cg::grid_group grid = cg::this_grid();
    const int wave = __builtin_amdgcn_readfirstlane((int)threadIdx.x >> 6);
#define LANE() lane_fresh()
#define TID() (wave * 64 + LANE())
    const int G = gridDim.x, bx = blockIdx.x;
    unsigned char* ws = a.ws;
    { volatile LAS unsigned* st0 = (volatile LAS unsigned*)(lds + LDS_BYTES - 128); if (wave == 0 && lane_fresh() < 2) st0[lane_fresh()] = 0u; }
    __syncthreads();
    const XcdBarrier xbar = xcd_barrier_post((unsigned*)(ws + WS_BAR), (volatile LAS unsigned*)(lds + LDS_BYTES - 128), wave == 0 && lane_fresh() == 0);
    const int gw = bx * 8 + wave, NGW = G * 8;

    prep_phase(a, lds, TID(), bx, G);
    for (int l = 0; l < 2; ++l) {
        { typedef __attribute__((address_space(1))) unsigned char gu8; gu8* wsg = (gu8*)ws; asm volatile("" : "+s"(wsg)); ws = (unsigned char*)wsg; }
        const float* modl = (const float*)(ws + WS_MOD) + l * 3 * 6144;
        bf16_t* XN = (bf16_t*)(ws + WS_XN) + DM;
        bf16_t* Pb = (bf16_t*)(ws + WS_P); bf16_t* Zt = (bf16_t*)(ws + WS_ZT); bf16_t* ZtC = (bf16_t*)(ws + WS_ZTC); bf16_t* A2t = (bf16_t*)(ws + WS_A2T);
        bf16_t* Yb = (bf16_t*)(ws + WS_Y); bf16_t* A2 = (bf16_t*)(ws + WS_A2); float* XC = (float*)(ws + WS_XC);
        unsigned char* wl = ws + WS_W + l * W_LAYER;
        const float* xin = l == 0 ? a.in[0] : a.out; const float* cin = l == 0 ? a.in[2] : XC;
        const bool ctxl = (l == 0);
        if (l == 0) {
            if (wave == 0 && lane_fresh() == 0) { unsigned sp = 0; while (xb_ld((unsigned*)(ws + WS_BAR) + 3648) < 192u && ++sp < (1u << 22)) __builtin_amdgcn_s_sleep(2);
                __builtin_amdgcn_fence(__ATOMIC_ACQUIRE, "agent"); asm volatile("s_waitcnt vmcnt(0)" ::: "memory"); }
            __syncthreads();
        }
        norm_phase(xin, cin, a.in[6] + l * DM, modl, 0, 1024, XN, true, gw, NGW, LANE(), XC, (const float*)(ws + WS_PART), (SPLITK && !ctxl) ? 11 : 0);
        GSYNC();
        {
            pg8::Gemm g{XN, (const bf16_t*)(wl + WO_IN), 1024, 0, (size_t)128 * 1024 * 2, (size_t)256 * 1024 * 2, 1024, 1024};
            pg8::TileOrder S; S.init(MT / 256, 9, G, bx);
            EpiWin E{Pb, Zt, ZtC, a.in[8] + l * 64, a.in[9] + l * 64, a.in[11] + l * 32, a.in[12] + l * 32, (const f32x2*)(ws + WS_ROPE)};
#ifndef NO_WIN
            for (int rep = 0; rep < REP_WIN; ++rep) {
                pg8::gemm_phase<EpiWin, pg8::TileOrder>(lds, g, S, E, wave);
                pg8::Gemm gz{XN, (const bf16_t*)(wl + WO_IN) + (size_t)2304 * 1024, 1024, 2, (size_t)256 * 1024 * 2, (size_t)0, 1024, 1024};
                pg8::TileOrder Sz; Sz.init(MT / 256, 2, G, (bx + G - 82) % G);
                EpiZ Ez{Zt, ZtC};
                pg8::gemm_phase<EpiZ, pg8::TileOrder>(lds, gz, Sz, Ez, wave);
            }
#endif
        }
        GSYNC();
        {
            unsigned* f1cnt = (unsigned*)(ws + WS_BAR) + 3520 + 64 * l;
#ifndef NO_NA
            for (int rep = 0; rep < REP_NA; ++rep)
            for (int u = bx; u < (ctxl ? 264 : 256); u += G) {
                if (u < 256) { const int xcd = u & 7, slot = u >> 3, b = slot >> 4, r = 16 * xcd + (slot & 15);
                    na_unit(lds, Pb, Yb, a.in[10] + l * 8 * 15 * 31, b * SEQ + 64 * r, b, r, wave, LANE()); }
                else { const int b = (u - 256) >> 2, qb = u & 3; na_unit(lds, Pb, Yb, a.in[10], NLAT + b * CTXL + 64 * qb, b, -1, wave, LANE()); }
            }
#endif
            __syncthreads();
            {
                pg8::Gemm g{(const bf16_t*)(ws + WS_M1), Zt, 256, 0, (size_t)128 * 256 * 2, (size_t)256 * 256 * 2, 256, 256};
                const int c1 = (bx + G / 2) % G;
                pg8::TileOrder S; S.init(1, 128, G, c1);
                EpiF1 E{A2t, (const f32x2*)(ws + WS_TW)};
#ifndef NO_F1
                pg8::gemm_phase<EpiF1, pg8::TileOrder>(lds, g, S, E, wave);
#endif
                if (c1 < 128) {
                    int n1 = 0; for (int L = c1; L < 128; L += G) ++n1;
                    if (wave == 0 && lane_fresh() == 0) { __builtin_amdgcn_fence(__ATOMIC_RELEASE, "agent"); asm volatile("s_waitcnt vmcnt(0)" ::: "memory"); xb_add(f1cnt, (unsigned)n1); }
                }
            }
            __syncthreads();
#ifndef NO_DIFF
            const float lam = ((const float*)(ws + WS_LAM))[2 * l], oms = ((const float*)(ws + WS_LAM))[2 * l + 1];
            for (int rep = 0; rep < REP_DIFF; ++rep)
            for (int u = bx; u < (ctxl ? 264 : 256); u += G) {
                int qrow0, b, h, t0;
                if (u < 256) { const int bh = u & 7, qb = u >> 3; b = bh >> 2; h = bh & 3; qrow0 = b * SEQ + 256 * qb; t0 = 0; }
                else { b = (u - 256) >> 2; h = u & 3; qrow0 = NLAT + b * CTXL; t0 = 128; }
                diff_unit(lds, Pb, Yb, a.in[14] + l * 64, qrow0, b, h, t0, 132, lam, oms, TID());
            }
#endif
            __syncthreads();
#ifndef NO_F2
            for (int pass = 0; pass < (ctxl ? 2 : 1); ++pass) {
                const int c2 = pass ? (bx + G - 72) % G : (bx + G - 8) % G;
                if (pass == 0 && c2 < 64) {
                    if (wave == 0 && lane_fresh() == 0) { unsigned sp = 0; while (xb_ld(f1cnt) < 128u && ++sp < (1u << 22)) __builtin_amdgcn_s_sleep(2);
                        __builtin_amdgcn_fence(__ATOMIC_ACQUIRE, "agent"); asm volatile("s_waitcnt vmcnt(0)" ::: "memory"); }
                    __syncthreads();
                }
                pg8::Gemm g{(const bf16_t*)(ws + (pass ? WS_MC : WS_M2)), pass ? ZtC : A2t, 512, 0, (size_t)128 * 512 * 2, (size_t)256 * 512 * 2, 512, 512};
                pg8::TileOrder S; S.init(1, pass ? 2 : 64, G, c2);
                EpiF2 E{Yb, pass};
                pg8::gemm_phase<EpiF2, pg8::TileOrder>(lds, g, S, E, wave);
            }
#endif
        }
        GSYNC();
        {
            for (int pass = 0; pass < ((ctxl && SPLITK) ? 2 : 1); ++pass) {
                pg8::Gemm g{Yb, (const bf16_t*)(wl + WO_OUT), pass ? 256 : 1024, 0, (size_t)128 * 1024 * 2, (size_t)256 * 1024 * 2, 1024, 1024};
                pg8::TileOrder S; S.init((ctxl && !SPLITK) ? 66 : 64, 4, G, bx, pass ? 4 : 0);
                EpiRes E{xin, a.out, XC, XC, modl + 2048, pass ? (float*)(ws + WS_PART) : nullptr};
                pg8::gemm_phase<EpiRes, pg8::TileOrder>(lds, g, S, E, wave);
            }
        }
        GSYNC();
#ifndef NO_NORM
        for (int rep = 0; rep < REP_NORM; ++rep) norm_phase(a.out, XC, a.in[17] + l * DM, modl, 3072, 4096, XN, ctxl, gw, NGW, LANE(), XC, (const float*)(ws + WS_PART), SPLITK ? 4 : 0);
#endif
        GSYNC();
        {
            const int Mrows = ctxl ? MT : NLAT;
            pg8::Gemm g{XN - DM, (const bf16_t*)(wl + WO_UP), 1024, 1, (size_t)4 * 1024 * 2, (size_t)252 * 1024 * 2, 1024, 1024};
            pg8::TileOrder S; S.init((Mrows + 251) / 252, 22, G, bx);
            EpiUp E{A2, a.in[19] + (size_t)l * 3 * 5632, a.in[20] + (size_t)l * 5632, Mrows};
#ifndef NO_UP
            for (int rep = 0; rep < REP_UP; ++rep) pg8::gemm_phase<EpiUp, pg8::TileOrder>(lds, g, S, E, wave);
#endif
        }
        GSYNC();
        {
            for (int pass = 0; pass < ((ctxl && SPLITK) ? 2 : 1); ++pass) {
                pg8::Gemm g{A2, (const bf16_t*)(wl + WO_DN), pass ? 256 : DFF, 0, (size_t)128 * DFF * 2, (size_t)256 * DFF * 2, DFF, DFF};
                pg8::TileOrder S; S.init((ctxl && !SPLITK) ? 66 : 64, 4, G, pass ? (bx + 128) % G : bx, pass ? 11 : 0);
                EpiRes E{a.out, a.out, XC, XC, modl + 5120, pass ? (float*)(ws + WS_PART) : nullptr};
                pg8::gemm_phase<EpiRes, pg8::TileOrder>(lds, g, S, E, wave);
            }
        }
        if (l == 0) GSYNC();
    }
}

extern "C" void kernel_launch(void* const* d_in, const int* in_sizes, int n_in, void* d_out, int out_size, void* d_ws, size_t ws_size, hipStream_t stream) {
    static int grid = 0;
    if (grid == 0) {
        if (n_in != 22 || out_size != NLAT * DM || ws_size < WS_END) { fprintf(stderr, "kernel_launch: unexpected shapes (n_in %d out %d ws %zu)\n", n_in, out_size, ws_size); grid = -1; return; }
        int dev = 0, cus = 0, per = 0;
        (void)hipGetDevice(&dev); (void)hipDeviceGetAttribute(&cus, hipDeviceAttributeMultiprocessorCount, dev);
        (void)hipFuncSetAttribute((const void*)hyb_fwd, hipFuncAttributeMaxDynamicSharedMemorySize, LDS_BYTES);
        (void)hipOccupancyMaxActiveBlocksPerMultiprocessor(&per, (const void*)hyb_fwd, 512, LDS_BYTES);
        (void)hipGetLastError();
        if (per < 1) fprintf(stderr, "kernel_launch: occupancy query says %d blocks/CU\n", per);
        grid = cus;
    }
    if (grid < 0) return;
    (void)hipMemsetAsync((unsigned char*)d_ws + WS_BAR, 0, 16384, stream);
    Args a{};
    for (int i = 0; i < 22; ++i) a.in[i] = (const float*)d_in[i];
    a.out = (float*)d_out; a.ws = (unsigned char*)d_ws;
    void* args[] = {&a};
    hipError_t e = hipLaunchCooperativeKernel((const void*)hyb_fwd, dim3(grid), dim3(512), args, LDS_BYTES, stream);
    if (e != hipSuccess) fprintf(stderr, "kernel_launch: cooperative launch failed: %s (grid %d)\n", hipGetErrorString(e), grid);
}
```
